# Optimizing an MI355X kernel written in HIP

```python
import jax, jax.numpy as jnp
from jax import lax
import numpy as np

D_MODEL = 1024
BATCH = 4
SEQ = 4096
DEPTH = 4

D_MIX = D_MODEL
GLA_HEADS = 4
GLA_DK = 64
GLA_DV = 128
GLA_WIDTH = GLA_HEADS * GLA_DV
GLA_KEY_WIDTH = GLA_HEADS * GLA_DK
GLA_GATE_RANK = 16
GLA_GATE_TEMP = 16.0
GLA_CHUNK = 64
MLA_HEADS = 4
MLA_NOPE = 128
MLA_ROPE = 64
MLA_QK = MLA_NOPE + MLA_ROPE
MLA_DV = 128
MLA_WIDTH = MLA_HEADS * MLA_DV
MLA_Q_RANK = 256
MLA_KV_RANK = 128
ROPE_THETA = 10000.0
Q_BLOCK = 128
EPS = 1e-6

IN_SPLITS = (GLA_KEY_WIDTH, GLA_KEY_WIDTH, GLA_WIDTH, GLA_GATE_RANK, GLA_WIDTH,
             MLA_Q_RANK, MLA_KV_RANK, MLA_ROPE, MLA_WIDTH)
D_IN = sum(IN_SPLITS)

kernel_name = "hymba_gla_mla_hybrid_trunk"


def rmsnorm(t, g):
    t32 = t.astype(jnp.float32)
    y = t32 * lax.rsqrt(jnp.mean(t32 * t32, axis=-1, keepdims=True) + EPS)
    return (y * g.astype(jnp.float32)).astype(t.dtype)


def apply_rope(t, cos, sin):
    half = t.shape[-1] // 2
    t32 = t.astype(jnp.float32)
    t1, t2 = t32[..., :half], t32[..., half:]
    return jnp.concatenate([t1 * cos - t2 * sin, t1 * sin + t2 * cos], axis=-1).astype(t.dtype)


def gla_mix(q, k, v, log_a, norm_g):
    B, S = q.shape[0], q.shape[1]
    n_chunks = S // GLA_CHUNK

    def to_chunks(t):
        return t.astype(jnp.float32).reshape(B, n_chunks, GLA_CHUNK, GLA_HEADS, -1).transpose(0, 3, 1, 2, 4)

    qc = to_chunks(q) * (GLA_DK ** -0.5)
    kc, vc, lac = to_chunks(k), to_chunks(v), to_chunks(log_a)
    b = jnp.cumsum(lac, axis=3)
    b_last = b[:, :, :, -1:, :]
    q_dec = qc * jnp.exp(b)
    k_inv = kc * jnp.exp(-b)
    k_end = kc * jnp.exp(b_last - b)

    causal = jnp.tril(jnp.ones((GLA_CHUNK, GLA_CHUNK), dtype=bool))
    a_intra = jnp.where(causal, jnp.einsum('bhnik,bhnjk->bhnij', q_dec, k_inv), 0.0)
    o_intra = jnp.einsum('bhnij,bhnjv->bhniv', a_intra, vc)

    chunk_update = jnp.einsum('bhnjk,bhnjv->bhnkv', k_end, vc)
    chunk_decay = jnp.exp(b_last[:, :, :, 0, :])

    def step(state, inp):
        decay, upd = inp
        return decay[..., None] * state + upd, state

    state0 = jnp.zeros((B, GLA_HEADS, GLA_DK, GLA_DV), jnp.float32)
    _, state_prev = lax.scan(step, state0,
                             (jnp.moveaxis(chunk_decay, 2, 0), jnp.moveaxis(chunk_update, 2, 0)))
    state_prev = jnp.moveaxis(state_prev, 0, 2)
    o_inter = jnp.einsum('bhnik,bhnkv->bhniv', q_dec, state_prev)

    o = (o_intra + o_inter).transpose(0, 2, 3, 1, 4).reshape(B, S, GLA_HEADS, GLA_DV)
    o = rmsnorm(o.astype(q.dtype), norm_g)
    return o.reshape(B, S, GLA_WIDTH)


def block_causal_attention(q, k, v):
    B, S = q.shape[0], q.shape[1]
    n_blocks = S // Q_BLOCK
    scale = MLA_QK ** -0.5
    kt = k.transpose(0, 2, 1, 3)
    vt = v.transpose(0, 2, 1, 3)
    qb = q.transpose(0, 2, 1, 3).reshape(B, MLA_HEADS, n_blocks, Q_BLOCK, MLA_QK).transpose(2, 0, 1, 3, 4)
    key_idx = jnp.arange(S)

    def one_block(args):
        q_blk, i = args
        s = jnp.einsum('bhqd,bhkd->bhqk', q_blk, kt).astype(jnp.float32) * scale
        q_idx = i * Q_BLOCK + jnp.arange(Q_BLOCK)
        s = jnp.where(key_idx[None, :] <= q_idx[:, None], s, -jnp.inf)
        p = jax.nn.softmax(s, axis=-1).astype(v.dtype)
        return jnp.einsum('bhqk,bhkd->bhqd', p, vt)

    o = lax.map(one_block, (qb, jnp.arange(n_blocks)))
    return o.transpose(1, 0, 3, 2, 4).reshape(B, S, MLA_HEADS * MLA_DV)


def setup_inputs(seed: int = 0) -> dict:
    key = jax.random.key(seed)
    ks = jax.random.split(key, 16)
    f32 = jnp.float32

    def w(k, shape, fan_in):
        return jax.random.normal(k, shape, f32) * (fan_in ** -0.5)

    def gain(k, shape):
        return 1.0 + 0.02 * jax.random.normal(k, shape, f32)

    x = jax.random.normal(ks[0], (BATCH, SEQ, D_MODEL), f32)
    offsets = jax.random.randint(ks[1], (BATCH, 1), 0, 1024, dtype=jnp.int32)
    positions = offsets + jnp.arange(SEQ, dtype=jnp.int32)[None, :]
    return {
        "x": x,
        "positions": positions,
        "norm_g": gain(ks[2], (DEPTH, D_MODEL)),
        "w_in": w(ks[3], (DEPTH, D_MODEL, D_IN), D_MODEL),
        "w_gla_gate_up": w(ks[4], (DEPTH, GLA_GATE_RANK, GLA_KEY_WIDTH), GLA_GATE_RANK),
        "b_gla_gate": 0.01 * jax.random.normal(ks[5], (DEPTH, GLA_KEY_WIDTH), f32),
        "gla_norm_g": gain(ks[6], (DEPTH, GLA_DV)),
        "mla_q_norm_g": gain(ks[7], (DEPTH, MLA_Q_RANK)),
        "w_uq": w(ks[8], (DEPTH, MLA_Q_RANK, MLA_HEADS * MLA_QK), MLA_Q_RANK),
        "mla_kv_norm_g": gain(ks[9], (DEPTH, MLA_KV_RANK)),
        "w_ukv": w(ks[10], (DEPTH, MLA_KV_RANK, MLA_HEADS * (MLA_NOPE + MLA_DV)), MLA_KV_RANK),
        "q_head_g": gain(ks[11], (DEPTH, MLA_QK)),
        "k_head_g": gain(ks[12], (DEPTH, MLA_QK)),
        "w_out": w(ks[13], (DEPTH, D_MIX, D_MODEL), D_MIX),
    }


def reference(x, positions, norm_g, w_in, w_gla_gate_up, b_gla_gate, gla_norm_g,
              mla_q_norm_g, w_uq, mla_kv_norm_g, w_ukv, q_head_g, k_head_g, w_out):
    B, S = x.shape[0], x.shape[1]
    split_idx = [int(v) for v in np.cumsum(IN_SPLITS)[:-1]]

    inv_freq = ROPE_THETA ** (-jnp.arange(0, MLA_ROPE, 2, dtype=jnp.float32) / MLA_ROPE)
    ang = positions.astype(jnp.float32)[..., None] * inv_freq
    cos = jnp.cos(ang)[:, :, None, :]
    sin = jnp.sin(ang)[:, :, None, :]

    for l in range(DEPTH):
        h = rmsnorm(x, norm_g[l])
        z = h @ w_in[l]
        (g_q, g_k, g_v, g_lr, g_gate,
         c_q, c_kv, k_pe, m_gate) = jnp.split(z, split_idx, axis=-1)

        gate_logit = (g_lr @ w_gla_gate_up[l] + b_gla_gate[l]).astype(jnp.float32)
        log_a = jax.nn.log_sigmoid(gate_logit) / GLA_GATE_TEMP
        o_gla = gla_mix(g_q.reshape(B, S, GLA_HEADS, GLA_DK),
                        g_k.reshape(B, S, GLA_HEADS, GLA_DK),
                        g_v.reshape(B, S, GLA_HEADS, GLA_DV),
                        log_a.reshape(B, S, GLA_HEADS, GLA_DK),
                        gla_norm_g[l])
        o_gla = o_gla * jax.nn.silu(g_gate)

        q = (rmsnorm(c_q, mla_q_norm_g[l]) @ w_uq[l]).reshape(B, S, MLA_HEADS, MLA_QK)
        kv = (rmsnorm(c_kv, mla_kv_norm_g[l]) @ w_ukv[l]).reshape(B, S, MLA_HEADS, MLA_NOPE + MLA_DV)
        k_nope, v = kv[..., :MLA_NOPE], kv[..., MLA_NOPE:]
        k_rope = jnp.broadcast_to(k_pe[:, :, None, :], (B, S, MLA_HEADS, MLA_ROPE))
        k = jnp.concatenate([k_nope, k_rope], axis=-1)
        q = rmsnorm(q, q_head_g[l])
        k = rmsnorm(k, k_head_g[l])
        q = jnp.concatenate([q[..., :MLA_NOPE], apply_rope(q[..., MLA_NOPE:], cos, sin)], axis=-1)
        k = jnp.concatenate([k[..., :MLA_NOPE], apply_rope(k[..., MLA_NOPE:], cos, sin)], axis=-1)
        o_mla = block_causal_attention(q, k, v) * jax.nn.silu(m_gate)

        x = x + jnp.concatenate([o_gla, o_mla], axis=-1) @ w_out[l]
    return x
```

```cpp
#include <hip/hip_runtime.h>
#include <hip/hip_cooperative_groups.h>
#include <cstdio>
#include <cstdint>
namespace cg = cooperative_groups;

#define DI __device__ __forceinline__
#define LAS __attribute__((address_space(3)))
typedef unsigned short bf16_t;
typedef short bf16x8 __attribute__((ext_vector_type(8)));
typedef short s16x4 __attribute__((ext_vector_type(4)));
typedef float f32x4 __attribute__((ext_vector_type(4)));
typedef float f32x16 __attribute__((ext_vector_type(16)));
typedef float f32x2 __attribute__((ext_vector_type(2)));
typedef unsigned u32x4 __attribute__((ext_vector_type(4)));
typedef unsigned u32x2 __attribute__((ext_vector_type(2)));
typedef __bf16 bf2_t __attribute__((ext_vector_type(2)));

DI unsigned pk2(float lo, float hi) { f32x2 v = {lo, hi}; return __builtin_bit_cast(unsigned, __builtin_convertvector(v, bf2_t)); }
DI bf16_t f2bf(float f) { return (bf16_t)(pk2(f, 0.f) & 0xffffu); }
DI float bf2f(bf16_t b) { return __uint_as_float((unsigned)b << 16); }
DI float bflo(unsigned w) { return __uint_as_float(w << 16); }
DI float bfhi(unsigned w) { return __uint_as_float(w & 0xffff0000u); }
DI int fresh_lane() { int l; asm volatile("v_mbcnt_lo_u32_b32 %0, -1, 0\n\tv_mbcnt_hi_u32_b32 %0, -1, %0" : "=v"(l)); return l; }
DI float shx(float v, int m, int lane) { return __int_as_float(__builtin_amdgcn_ds_bpermute((lane ^ m) << 2, __float_as_int(v))); }
#define DPP_ROR(v, n) __int_as_float(__builtin_amdgcn_update_dpp(0, __float_as_int(v), 0x120 + (n), 0xf, 0xf, false))
DI float red16(float v, int lane) { (void)lane; v += DPP_ROR(v, 1); v += DPP_ROR(v, 2); v += DPP_ROR(v, 4); v += DPP_ROR(v, 8); return v; }
DI float wave_sum(float v, int lane) {
    v = red16(v, lane);
    const int iv = __float_as_int(v);
    return (__int_as_float(__builtin_amdgcn_readlane(iv, 0)) + __int_as_float(__builtin_amdgcn_readlane(iv, 16))) + (__int_as_float(__builtin_amdgcn_readlane(iv, 32)) + __int_as_float(__builtin_amdgcn_readlane(iv, 48)));
}

constexpr int T = 16384, SEQ = 4096, DM = 1024, DEPTH = 4, DIN = 2512, N1 = 2560;
constexpr float EPS = 1e-6f;
constexpr int ZLD = 2048;
constexpr int Z_GQ = 0, Z_GK = 256, Z_GV = 512, Z_GG = 1024, Z_MG = 1536;

constexpr size_t MiB = 1u << 20;
constexpr size_t WS_WIN = 1 * MiB;
constexpr size_t WS_WOUT = 21 * MiB;
constexpr size_t WS_WUP = 29 * MiB;
constexpr int WUP_ROWS = 1792;
constexpr size_t WS_WGT = 128 * 1024;
constexpr size_t WS_SM = 192 * 1024;
constexpr size_t WS_COS = 33 * MiB;
constexpr size_t WS_SIN = 35 * MiB;
constexpr size_t WS_SSQ = 37 * MiB;
constexpr size_t WS_XB = 38 * MiB;
constexpr size_t WS_Z = 70 * MiB;
constexpr size_t WS_CQ = 134 * MiB;
constexpr size_t WS_MISC = 142 * MiB;
constexpr size_t WS_QR = 150 * MiB;
constexpr size_t WS_KVR = 174 * MiB;
constexpr size_t WS_K = 206 * MiB;
constexpr size_t WS_VT = 230 * MiB;
constexpr size_t WS_DEC = 246 * MiB;
constexpr size_t WS_BC = 247 * MiB;
constexpr size_t WS_END = 255 * MiB;

constexpr int CW_LATE = 8192;
constexpr int LDS_BYTES = 147456;

namespace pg8 {
constexpr int BM = 256, BK = 64, HALF = 128, HTB = HALF * BK * 2, STAGE_BYTES = 8 * HTB, NXCD = 8, WGM = 8;
__host__ __device__ __forceinline__ int lds_byte(int r, int c) { const int st = (r >> 4) * 2 + (c >> 5), rr = r & 15, cc = c & 31, ob = rr * 64 + cc * 2; return st * 1024 + (ob ^ (((ob >> 9) & 1) << 5)); }
__host__ __device__ __forceinline__ void stage_rc(int b, int& R, int& C) { const int st = b / 1024, sb = b % 1024, swz = sb ^ (((sb >> 9) & 1) << 5); R = (st >> 1) * 16 + swz / 64; C = (st & 1) * 32 + (swz % 64) / 2; }
__host__ __device__ __forceinline__ int perm32(int rho) { const int n = rho >> 4, i = rho & 15; return 8 * (i >> 2) + 4 * n + (i & 3); }
struct Unit { int pm, pn; };
struct Gemm { const bf16_t* A; const bf16_t* Bt; int M, N, K; };
struct StaticOrder {
    int nM, nN, nwg, G, c, mode, lim;
    __device__ void init(int M, int N, int G_, int c_) { nM = M / BM; nN = N / BM; nwg = nM * nN; G = G_; c = c_; mode = 0; lim = nwg; }
    __device__ void init_up(int first, int stride, int lim_) { c = first; G = stride; lim = lim_; mode = 1; nM = 128; nN = 7; nwg = 448; }
    __device__ void init_in(int first, int stride, int lim_) { c = first; G = stride; lim = lim_; mode = 2; nM = 64; nN = 10; nwg = 640; }
    __device__ bool next(int i, Unit& u) const {
        const long L = (long)i * G + c; if (L >= lim) return false;
        if (mode == 1) { const int x = (int)L; if (x < 256) { u.pm = 64 + (x >> 2); u.pn = 3 + (x & 3); } else { const int y = x - 256; u.pm = y / 3; u.pn = y - 3 * u.pm; } return true; }
        if (mode == 2) { int x = (int)L; const bool late = x >= 320; if (late) x -= 320; u.pm = x / 5; const int t5 = x - 5 * u.pm;
            u.pn = late ? (t5 == 0 ? 0 : (t5 < 3 ? 3 + t5 : 5 + t5)) : (t5 < 3 ? 1 + t5 : 3 + t5); return true; }
        int wgid = (int)L; { const int q = nwg / NXCD, r = nwg % NXCD, xcd = wgid % NXCD, off = wgid / NXCD; wgid = (xcd < r ? xcd * (q + 1) : r * (q + 1) + (xcd - r) * q) + off; }
        const int nig = WGM * nN, gid = wgid / nig, fm = gid * WGM, gsz = (nM - fm) < WGM ? (nM - fm) : WGM;
        u.pm = fm + ((wgid % nig) % gsz); u.pn = (wgid % nig) / gsz; return true;
    }
};
template <class Epi, bool PERM = true, bool DBLK = false>
__device__ __forceinline__ void gemm_phase(LAS unsigned char* lds, const Gemm g, const StaticOrder& S, const Epi& E, const int tid) {
    const int wid = __builtin_amdgcn_readfirstlane(tid >> 6), lane = tid & 63, wr = wid >> 2, wc = wid & 3, fr = lane & 15, fq = lane >> 4;
    const int K = g.K, nt = K / BK;
    unsigned voffA[2], voffB[2];
#pragma unroll
    for (int i = 0; i < 2; ++i) { int R, C; stage_rc(tid * 16 + i * 8192, R, C); const int Rb = PERM ? ((R & ~31) + perm32(R & 31)) : R;
        voffA[i] = (unsigned)(R * K + C) * 2u; voffB[i] = (unsigned)(Rb * K + C) * 2u; }
    const size_t kstep = (size_t)(BK * 2);
    const size_t hstep = (size_t)HALF * K * 2;
    const size_t tstep = 2 * hstep;
    const unsigned ldsw = (unsigned)wid * 1024u;
    const int aoff = lds_byte(wr * 64 + fr, fq * 8), boff = lds_byte(wc * 32 + fr, fq * 8);
#define PG8_SA(b, h) (((b) * 2 + (h)) * HTB)
#define PG8_SB(b, h) ((4 + (b) * 2 + (h)) * HTB)
#define PG8_STAGE(bufoff, gbase, voff) do { _Pragma("unroll") for (int _i = 0; _i < 2; ++_i) \
        __builtin_amdgcn_global_load_lds((const unsigned*)((const char*)(gbase) + (voff)[_i]), (LAS unsigned*)(lds + (bufoff) + ldsw + _i * 8192), 16, 0, 0); } while (0)
#define PG8_LDA(dst, b, h) do { _Pragma("unroll") for (int m = 0; m < 4; ++m) _Pragma("unroll") for (int k = 0; k < 2; ++k) dst[m][k] = *(const LAS bf16x8*)(lds + PG8_SA(b, h) + aoff + m * 2048 + k * 1024); } while (0)
#define PG8_LDB(dst, b, h) do { _Pragma("unroll") for (int n = 0; n < 2; ++n) _Pragma("unroll") for (int k = 0; k < 2; ++k) dst[n][k] = *(const LAS bf16x8*)(lds + PG8_SB(b, h) + boff + n * 2048 + k * 1024); } while (0)
#define PG8_MMA(ai, bj, At, Bt) do { __builtin_amdgcn_s_setprio(1); _Pragma("unroll") for (int m = 0; m < 4; ++m) _Pragma("unroll") for (int n = 0; n < 2; ++n) _Pragma("unroll") for (int k = 0; k < 2; ++k) \
        acc[ai][bj][m][n] = __builtin_amdgcn_mfma_f32_16x16x32_bf16(Bt[n][k], At[m][k], acc[ai][bj][m][n], 0, 0, 0); __builtin_amdgcn_s_setprio(0); } while (0)
#define PG8_WAIT_V(n) asm volatile("s_waitcnt vmcnt(" #n ")" ::: "memory")
#define PG8_WAIT_L(n) asm volatile("s_waitcnt lgkmcnt(" #n ")" ::: "memory")
#define PG8_BAR __builtin_amdgcn_s_barrier()
#define PG8_SCHED __builtin_amdgcn_sched_barrier(0)
    Unit cur, nxt; int ui = 0;
    if (!S.next(0, cur)) return;
    f32x4 acc[2][2][4][2];
#pragma unroll
    for (int a = 0; a < 2; ++a)
#pragma unroll
        for (int b = 0; b < 2; ++b)
#pragma unroll
            for (int m = 0; m < 4; ++m)
#pragma unroll
                for (int n = 0; n < 2; ++n) acc[a][b][m][n] = (f32x4){0.f, 0.f, 0.f, 0.f};
    bf16x8 At[4][2], B0[2][2], B1[2][2];
    const char* cA = (const char*)g.A + (size_t)cur.pm * tstep; const char* cB = (const char*)g.Bt + (size_t)cur.pn * tstep;
    PG8_STAGE(PG8_SB(0, 0), cB, voffB); PG8_STAGE(PG8_SB(0, 1), cB + hstep, voffB); PG8_STAGE(PG8_SA(0, 0), cA, voffA); PG8_STAGE(PG8_SA(0, 1), cA + hstep, voffA);
    if (wr == 1) PG8_BAR;
    PG8_WAIT_V(2); PG8_BAR;
    PG8_STAGE(PG8_SB(1, 0), cB + kstep, voffB); PG8_STAGE(PG8_SA(1, 0), cA + kstep, voffA); PG8_STAGE(PG8_SB(1, 1), cB + hstep + kstep, voffB);
    PG8_WAIT_V(6); PG8_BAR;
    for (;;) {
        const bool has_next = S.next(ui + 1, nxt);
        const char* nA = has_next ? (const char*)g.A + (size_t)nxt.pm * tstep : cA; const char* nB = has_next ? (const char*)g.Bt + (size_t)nxt.pn * tstep : cB;
        for (int t2 = 0; t2 < (DBLK ? 2 * nt : nt); t2 += 2) {
            const int t = DBLK ? (t2 >= nt ? t2 - nt : t2) : t2;
            const bool lastp = (t == nt - 2);
            const bool last = DBLK ? (t2 == 2 * nt - 2) : lastp;
            const char* a1 = cA + (size_t)(t + 1) * kstep;
            const char* a2 = last ? nA : (lastp ? cA : cA + (size_t)(t + 2) * kstep); const char* b2 = last ? nB : (lastp ? cB : cB + (size_t)(t + 2) * kstep);
            const char* a3 = a2 + kstep; const char* b3 = b2 + kstep;
            PG8_LDB(B0, 0, 0); PG8_LDB(B1, 0, 1); PG8_SCHED; PG8_LDA(At, 0, 0); PG8_STAGE(PG8_SA(1, 1), a1 + hstep, voffA);
            PG8_WAIT_V(8); PG8_WAIT_L(0); PG8_BAR; PG8_MMA(0, 0, At, B0); PG8_MMA(0, 1, At, B1); PG8_BAR; PG8_SCHED;
            PG8_LDA(At, 0, 1); PG8_STAGE(PG8_SB(0, 0), b2, voffB); PG8_STAGE(PG8_SB(0, 1), b2 + hstep, voffB); PG8_STAGE(PG8_SA(0, 0), a2, voffA);
            PG8_WAIT_V(8); PG8_WAIT_L(0); PG8_BAR; PG8_MMA(1, 0, At, B0); PG8_MMA(1, 1, At, B1); PG8_BAR; PG8_SCHED;
            PG8_LDB(B0, 1, 0); PG8_LDB(B1, 1, 1); PG8_SCHED; PG8_LDA(At, 1, 0); PG8_STAGE(PG8_SA(0, 1), a2 + hstep, voffA);
            PG8_WAIT_V(8); PG8_WAIT_L(0); PG8_BAR; PG8_MMA(0, 0, At, B0); PG8_MMA(0, 1, At, B1); PG8_BAR; PG8_SCHED;
            PG8_LDA(At, 1, 1); PG8_STAGE(PG8_SB(1, 0), b3, voffB); PG8_STAGE(PG8_SB(1, 1), b3 + hstep, voffB); PG8_STAGE(PG8_SA(1, 0), a3, voffA);
            PG8_WAIT_V(8); PG8_WAIT_L(0); PG8_BAR; PG8_MMA(1, 0, At, B0); PG8_MMA(1, 1, At, B1); PG8_BAR; PG8_SCHED;
        }
        if (wr == 0) PG8_BAR;
        if (DBLK) {
#pragma unroll
            for (int a = 0; a < 2; ++a)
#pragma unroll
                for (int b = 0; b < 2; ++b)
#pragma unroll
                    for (int m = 0; m < 4; ++m)
#pragma unroll
                        for (int n = 0; n < 2; ++n) acc[a][b][m][n] *= 0.5f;
        }
        if (!Epi::AFTER_DRAIN || has_next) E(acc, cur, wr, wc, fr, fq);
        if (!has_next) break;
#pragma unroll
        for (int a = 0; a < 2; ++a)
#pragma unroll
            for (int b = 0; b < 2; ++b)
#pragma unroll
                for (int m = 0; m < 4; ++m)
#pragma unroll
                    for (int n = 0; n < 2; ++n) acc[a][b][m][n] = (f32x4){0.f, 0.f, 0.f, 0.f};
        cur = nxt; cA = nA; cB = nB; ++ui;
        if (wr == 1) PG8_BAR;
    }
    PG8_WAIT_V(0);
    PG8_BAR;
    if constexpr (Epi::AFTER_DRAIN) E.fused(acc, cur, wr, wc, lds);
#undef PG8_SA
#undef PG8_SB
#undef PG8_STAGE
#undef PG8_LDA
#undef PG8_LDB
#undef PG8_MMA
#undef PG8_WAIT_V
#undef PG8_WAIT_L
#undef PG8_BAR
#undef PG8_SCHED
}
}

struct EpiZ {
    static constexpr bool AFTER_DRAIN = false;
    bf16_t* Z; bf16_t* CQ; bf16_t* MISC; const float* ssq;
    DI void operator()(const f32x4 (&acc)[2][2][4][2], const pg8::Unit& u, int wr, int wc, int, int) const {
        const int lane_ = fresh_lane(), fr = lane_ & 15, fq = lane_ >> 4; (void)lane_;
        const int row0 = u.pm * 256 + wr * 64 + fr;
        bf16_t* base; int ldc, colt;
        if (u.pn == 6) { base = CQ; ldc = 256; colt = 0; }
        else if (u.pn == 7) { base = MISC; ldc = 256; colt = 0; }
        else { base = Z; ldc = ZLD; colt = (u.pn < 6 ? u.pn : u.pn - 2) * 256; }
        const int col0 = colt + wc * 32 + 8 * fq;
        float rs[2][4];
#pragma unroll
        for (int ai = 0; ai < 2; ++ai)
#pragma unroll
            for (int m = 0; m < 4; ++m) {
                const f32x4* sp = (const f32x4*)(ssq + (size_t)(row0 + ai * 128 + m * 16) * 16); const f32x4 q0 = sp[0], q1 = sp[1], q2 = sp[2], q3 = sp[3];
                rs[ai][m] = rsqrtf((((q0.x + q0.y) + (q0.z + q0.w)) + ((q1.x + q1.y) + (q1.z + q1.w)) + ((q2.x + q2.y) + (q2.z + q2.w)) + ((q3.x + q3.y) + (q3.z + q3.w))) * (1.0f / DM) + EPS);
            }
#pragma unroll
        for (int ai = 0; ai < 2; ++ai)
#pragma unroll
            for (int m = 0; m < 4; ++m) {
                const int r = row0 + ai * 128 + m * 16;
                bf16_t* rowp = base + (size_t)r * ldc + col0;
#pragma unroll
                for (int bj = 0; bj < 2; ++bj) {
                    const f32x4 v0 = acc[ai][bj][m][0] * rs[ai][m], v1 = acc[ai][bj][m][1] * rs[ai][m];
                    u32x4 w; w.x = pk2(v0[0], v0[1]); w.y = pk2(v0[2], v0[3]); w.z = pk2(v1[0], v1[1]); w.w = pk2(v1[2], v1[3]);
                    *(u32x4*)(rowp + bj * 128) = w;
                }
            }
    }
};
struct EpiRaw {
    static constexpr bool AFTER_DRAIN = false;
    bf16_t* O; int ldc;
    DI void operator()(const f32x4 (&acc)[2][2][4][2], const pg8::Unit& u, int wr, int wc, int, int) const {
        const int lane_ = fresh_lane(), fr = lane_ & 15, fq = lane_ >> 4; (void)lane_;
        const int row0 = u.pm * 256 + wr * 64 + fr;
        const int col0 = u.pn * 256 + wc * 32 + 8 * fq;
#pragma unroll
        for (int ai = 0; ai < 2; ++ai)
#pragma unroll
            for (int m = 0; m < 4; ++m) {
                bf16_t* rowp = O + (size_t)(row0 + ai * 128 + m * 16) * ldc + col0;
#pragma unroll
                for (int bj = 0; bj < 2; ++bj) {
                    const f32x4 v0 = acc[ai][bj][m][0], v1 = acc[ai][bj][m][1];
                    u32x4 w; w.x = pk2(v0[0], v0[1]); w.y = pk2(v0[2], v0[3]); w.z = pk2(v1[0], v1[1]); w.w = pk2(v1[2], v1[3]);
                    *(u32x4*)(rowp + bj * 128) = w;
                }
            }
    }
};
struct EpiUp {
    static constexpr bool AFTER_DRAIN = false;
    bf16_t* QRp; bf16_t* KVRp;
    DI void operator()(const f32x4 (&acc)[2][2][4][2], const pg8::Unit& u, int wr, int wc, int, int) const {
        const int lane_ = fresh_lane(), fr = lane_ & 15, fq = lane_ >> 4; (void)lane_;
        const bool isq = u.pm < 64;
        bf16_t* O = isq ? QRp : KVRp; const int ldc = isq ? 768 : 1024;
        const int row0 = (isq ? u.pm : u.pm - 64) * 256 + wr * 64 + fr;
        const int col0 = (isq ? u.pn : u.pn - 3) * 256 + wc * 32 + 8 * fq;
#pragma unroll
        for (int ai = 0; ai < 2; ++ai)
#pragma unroll
            for (int m = 0; m < 4; ++m) {
                bf16_t* rowp = O + (size_t)(row0 + ai * 128 + m * 16) * ldc + col0;
#pragma unroll
                for (int bj = 0; bj < 2; ++bj) {
                    const f32x4 v0 = acc[ai][bj][m][0], v1 = acc[ai][bj][m][1];
                    u32x4 w; w.x = pk2(v0[0], v0[1]); w.y = pk2(v0[2], v0[3]); w.z = pk2(v1[0], v1[1]); w.w = pk2(v1[2], v1[3]);
                    *(u32x4*)(rowp + bj * 128) = w;
                }
            }
    }
};
struct EpiOut {
    static constexpr bool AFTER_DRAIN = true;
    const float* xin; float* xout; bf16_t* XB; float* ssq_next;
    template <int B> DI void load(f32x4 (&xv)[2][4], int row0, int col0) const {
#pragma unroll
        for (int q = 0; q < 2; ++q)
#pragma unroll
            for (int bj = 0; bj < 2; ++bj) { const size_t off = (size_t)(row0 + (B >> 1) * 128 + (2 * (B & 1) + q) * 16) * DM + col0 + bj * 128;
                xv[q][bj * 2] = *(const f32x4*)(xin + off); xv[q][bj * 2 + 1] = *(const f32x4*)(xin + off + 16); }
    }
    template <int B> DI void proc(const f32x4 (&acc)[2][2][4][2], const f32x4 (&xv)[2][4], int row0, int col0, int pn, int wc, int fq, int lane_) const {
#pragma unroll
        for (int q = 0; q < 2; ++q) {
            constexpr int ai = B >> 1; const int m = 2 * (B & 1) + q;
            const int r = row0 + ai * 128 + m * 16;
            float part = 0.f;
#pragma unroll
            for (int bj = 0; bj < 2; ++bj) {
                const size_t off = (size_t)r * DM + col0 + bj * 128;
                const f32x4 v0 = acc[ai][bj][m][0] + xv[q][bj * 2], v1 = acc[ai][bj][m][1] + xv[q][bj * 2 + 1];
                *(f32x4*)(xout + off) = v0; *(f32x4*)(xout + off + 16) = v1;
                if (XB) {
                    *(u32x2*)(XB + off) = (u32x2){pk2(v0[0], v0[1]), pk2(v0[2], v0[3])};
                    *(u32x2*)(XB + off + 16) = (u32x2){pk2(v1[0], v1[1]), pk2(v1[2], v1[3])};
                    part += (v0[0] * v0[0] + v0[1] * v0[1]) + (v0[2] * v0[2] + v0[3] * v0[3]) + (v1[0] * v1[0] + v1[1] * v1[1]) + (v1[2] * v1[2] + v1[3] * v1[3]);
                }
            }
            if (XB) {
                part += shx(part, 16, lane_); part += shx(part, 32, lane_);
                if (fq == 0) ssq_next[(size_t)r * 16 + pn * 4 + wc] = part;
            }
        }
    }
    DI void fused(const f32x4 (&acc)[2][2][4][2], const pg8::Unit& u, int wr, int wc, LAS unsigned char* lds) const {
        const int lane_ = fresh_lane(), fr = lane_ & 15, fq = lane_ >> 4;
        const int w8 = wr * 4 + wc;
#pragma unroll
        for (int ai = 0; ai < 2; ++ai) {
#pragma unroll
            for (int m = 0; m < 4; ++m)
#pragma unroll
                for (int bj = 0; bj < 2; ++bj)
#pragma unroll
                    for (int n = 0; n < 2; ++n)
                        *(LAS f32x4*)(lds + (size_t)(wr * 64 + m * 16 + fr) * 1040 + (bj * 128 + wc * 32 + n * 16 + 4 * fq) * 4) = acc[ai][bj][m][n];
            __syncthreads();
            const size_t g0 = (size_t)(u.pm * 256 + ai * 128 + w8 * 16) * DM + u.pn * 256 + lane_ * 4;
            f32x4 xo[16];
#pragma unroll
            for (int rr = 0; rr < 16; ++rr) xo[rr] = *(const f32x4*)(xin + g0 + (size_t)rr * DM);
#pragma unroll
            for (int rr = 0; rr < 16; ++rr) {
                const f32x4 a = *(const LAS f32x4*)(lds + (size_t)(w8 * 16 + rr) * 1040 + lane_ * 16);
                const f32x4 v = a + xo[rr];
                *(f32x4*)(xout + g0 + (size_t)rr * DM) = v;
                if (XB) {
                    *(u32x2*)(XB + g0 + (size_t)rr * DM) = (u32x2){pk2(v[0], v[1]), pk2(v[2], v[3])};
                    float part = (v[0] * v[0] + v[1] * v[1]) + (v[2] * v[2] + v[3] * v[3]);
                    part = wave_sum(part, lane_);
                    if (lane_ < 4) ssq_next[(size_t)(u.pm * 256 + ai * 128 + w8 * 16 + rr) * 16 + u.pn * 4 + lane_] = (lane_ == 0) ? part : 0.f;
                }
            }
            __syncthreads();
        }
    }
    DI void operator()(const f32x4 (&acc)[2][2][4][2], const pg8::Unit& u, int wr, int wc, int, int) const {
        const int lane_ = fresh_lane(), fr = lane_ & 15, fq = lane_ >> 4;
        const int row0 = u.pm * 256 + wr * 64 + fr;
        const int col0 = u.pn * 256 + wc * 32 + 4 * fq;
        f32x4 xa[2][4], xb[2][4];
        load<0>(xa, row0, col0); load<1>(xb, row0, col0);
        proc<0>(acc, xa, row0, col0, u.pn, wc, fq, lane_); load<2>(xa, row0, col0);
        proc<1>(acc, xb, row0, col0, u.pn, wc, fq, lane_); load<3>(xb, row0, col0);
        proc<2>(acc, xa, row0, col0, u.pn, wc, fq, lane_);
        proc<3>(acc, xb, row0, col0, u.pn, wc, fq, lane_);
    }
};

struct Params {
    const float* x; const int* pos; const float* norm_g; const float* w_in; const float* w_gate_up; const float* b_gate;
    const float* gla_norm_g; const float* q_norm_g; const float* w_uq; const float* kv_norm_g; const float* w_ukv;
    const float* q_head_g; const float* k_head_g; const float* w_out;
    float* out; unsigned char* ws;
};

DI int map_in(int n) { return n < 1024 ? n : (n < 1984 ? n + 16 : (n < 2000 ? n - 960 : (n < 2048 ? -1 : n - 48))); }
DI void tr_item(const float* W, int ldw, const float* gain, bf16_t* WT, int ldk, int k0, int n0, bool remap, LAS float* scr, int lane) {
    const int nq = (lane & 7) * 4, kr = lane >> 3; const int nn = n0 + nq; const int src = remap ? map_in(nn) : nn;
    f32x4 v[8];
#pragma unroll
    for (int i = 0; i < 8; ++i) { const int kk = 8 * i + kr;
        v[i] = (f32x4){0.f, 0.f, 0.f, 0.f}; if (src >= 0) { v[i] = *(const f32x4*)(W + (size_t)(k0 + kk) * ldw + src); if (gain) v[i] = v[i] * gain[k0 + kk]; } }
#pragma unroll
    for (int i = 0; i < 8; ++i) *(LAS f32x4*)(scr + (8 * i + kr) * 36 + nq) = v[i];
    asm volatile("s_waitcnt lgkmcnt(0)" ::: "memory");
    const int c = lane & 7;
#pragma unroll
    for (int j = 0; j < 4; ++j) { const int n = (lane >> 3) + 8 * j; const LAS float* s = scr + (8 * c) * 36 + n;
        u32x4 o; o.x = pk2(s[0 * 36], s[1 * 36]); o.y = pk2(s[2 * 36], s[3 * 36]); o.z = pk2(s[4 * 36], s[5 * 36]); o.w = pk2(s[6 * 36], s[7 * 36]);
        *(u32x4*)(WT + (size_t)(n0 + n) * ldk + k0 + 8 * c) = o; }
    asm volatile("s_waitcnt lgkmcnt(0)" ::: "memory");
}
DI void p0_prologue(const Params& p, LAS unsigned char* lds, int tid, int lane, int wave) {
    unsigned char* ws = p.ws;
    LAS float* scr = (LAS float*)(lds + wave * 9216);
    const int gw = blockIdx.x * 8 + wave, NGW = gridDim.x * 8;
    const int gt = blockIdx.x * 512 + tid, NT = gridDim.x * 512;
    constexpr int IT_IN = 16 * 80, IT_OUT = 16 * 32, IT_UQ = 4 * 24, IT_UKV = 2 * 32, IT_L = IT_IN + IT_OUT + IT_UQ + IT_UKV;
    for (int it = gw; it < DEPTH * IT_L; it += NGW) {
        const int l = it / IT_L; int r = it % IT_L;
        if (r < IT_IN) { tr_item(p.w_in + (size_t)l * DM * DIN, DIN, p.norm_g + l * DM, (bf16_t*)(ws + WS_WIN) + (size_t)l * N1 * DM, DM, 64 * (r / 80), 32 * (r % 80), true, scr, lane); continue; } r -= IT_IN;
        if (r < IT_OUT) { tr_item(p.w_out + (size_t)l * DM * DM, DM, nullptr, (bf16_t*)(ws + WS_WOUT) + (size_t)l * DM * DM, DM, 64 * (r / 32), 32 * (r % 32), false, scr, lane); continue; } r -= IT_OUT;
        if (r < IT_UQ) { tr_item(p.w_uq + (size_t)l * 256 * 768, 768, p.q_norm_g + l * 256, (bf16_t*)(ws + WS_WUP) + (size_t)l * WUP_ROWS * 256, 256, 64 * (r / 24), 32 * (r % 24), false, scr, lane); continue; } r -= IT_UQ;
        tr_item(p.w_ukv + (size_t)l * 128 * 1024, 1024, p.kv_norm_g + l * 128, (bf16_t*)(ws + WS_WUP) + ((size_t)l * WUP_ROWS + 768) * 256, 256, 64 * (r / 32), 32 * (r % 32), false, scr, lane);
    }
    for (int i = gt; i < DEPTH * 1024 * 16; i += NT) { const int ln = i >> 4, c = i & 15; *(u32x4*)((bf16_t*)(ws + WS_WUP) + ((size_t)(ln >> 10) * WUP_ROWS + 768 + (ln & 1023)) * 256 + 128 + c * 8) = (u32x4){0u, 0u, 0u, 0u}; }
    for (int i = gt; i < DEPTH * 256 * 16; i += NT) { const int r = i & 15, c = (i >> 4) & 255, ll = i >> 12; ((float*)(ws + WS_WGT))[i] = p.w_gate_up[((size_t)ll * 16 + r) * 256 + c]; }
    for (int i = gt; i < 3072; i += NT) { float v; if (i < 1024) v = p.b_gate[i]; else if (i < 1536) v = p.gla_norm_g[i - 1024]; else if (i < 2304) v = p.q_head_g[i - 1536]; else v = p.k_head_g[i - 2304]; ((float*)(ws + WS_SM))[i] = v; }
    float* COS = (float*)(ws + WS_COS); float* SIN = (float*)(ws + WS_SIN);
    for (int i = gt; i < T * 32; i += NT) { const int t = i >> 5, j = i & 31;
        const float inv = exp2f(-(float)j * (13.287712379549449f / 32.0f));
        const float ang = (float)p.pos[t] * inv;
        const float n = rintf(ang * 0.15915494309189535f);
        float r = fmaf(-n, 6.2831855f, ang); r = fmaf(-n, -1.7484555e-7f, r);
        COS[i] = __cosf(r); SIN[i] = __sinf(r); }
    float* SSQ = (float*)(ws + WS_SSQ); bf16_t* XB = (bf16_t*)(ws + WS_XB);
    for (int m0 = gw * 4; m0 < T; m0 += NGW * 4) {
        f32x4 v[4][4];
#pragma unroll
        for (int q = 0; q < 4; ++q)
#pragma unroll
            for (int j = 0; j < 4; ++j) v[q][j] = ((const f32x4*)(p.x + (size_t)(m0 + q) * DM) + lane)[64 * j];
#pragma unroll
        for (int q = 0; q < 4; ++q) {
            float s = 0.f;
            unsigned long long* o8 = (unsigned long long*)(XB + (size_t)(m0 + q) * DM) + lane;
#pragma unroll
            for (int j = 0; j < 4; ++j) { const f32x4 w = v[q][j]; s += (w.x * w.x + w.y * w.y) + (w.z * w.z + w.w * w.w);
                o8[64 * j] = (unsigned long long)pk2(w.x, w.y) | ((unsigned long long)pk2(w.z, w.w) << 32); }
            s = wave_sum(s, lane); if (lane < 16) SSQ[(size_t)(m0 + q) * 16 + lane] = (lane == 0) ? s : 0.f;
        }
    }
}

constexpr int GS = 80;
constexpr int GL_QD = 0, GL_KI = 10240, GL_AT = 20480, GL_VT = 30720, GL_SP = 51200, GL_LR = 71680, GL_TOT = 75776, GL_RS = 77824, GL_GT = 79872  , GL_OT = 97280  , GL_UT = 0  ;
DI float logsigmoid16(float x) { return (fminf(x, 0.f) - __logf(1.f + __expf(-fabsf(x)))) * (1.0f / 16.0f); }
#define MFMA16(a, b, c) __builtin_amdgcn_mfma_f32_16x16x32_bf16((a), (b), (c), 0, 0, 0)
#define MFMA32(a, b, c) __builtin_amdgcn_mfma_f32_32x32x16_bf16((a), (b), (c), 0, 0, 0)
DI bf16x8 lds_frag(LAS unsigned char* lds, int base, int row, int kel) { return *(const LAS bf16x8*)(lds + base + row * (2 * GS) + kel * 2); }

template <bool P3> struct GlaIn;
template <> struct GlaIn<false> { u32x4 vt[2]; unsigned lr[2]; unsigned kq[8]; f32x4 wup[4]; float bias; };
template <> struct GlaIn<true>  { u32x4 vt[2]; u32x4 bc; unsigned kq[8]; f32x4 sp[4]; u32x4 gt[2]; float gn[4]; };

template <bool P3> DI void gla_load(const Params& p, int l, int item, int tid, int lane, int wave, GlaIn<P3>& g) {
    const int c = item >> 2, h = item & 3, t0 = c * 64;
    const bf16_t* Z = (const bf16_t*)(p.ws + WS_Z); const bf16_t* MISC = (const bf16_t*)(p.ws + WS_MISC);
#pragma unroll
    for (int e = 0; e < 2; ++e) g.vt[e] = *(const u32x4*)(Z + (size_t)(t0 + lane) * ZLD + Z_GV + h * 128 + (wave + 8 * e) * 8);
    if constexpr (!P3) {
#pragma unroll
        for (int e = 0; e < 2; ++e) { const int i = tid + e * 512; g.lr[e] = MISC[(size_t)(t0 + (i >> 4)) * 256 + 192 + (i & 15)]; }
    } else g.bc = *(const u32x4*)((const unsigned short*)(p.ws + WS_BC) + ((size_t)item * 64 + lane) * 64 + wave * 8);
#pragma unroll
    for (int jj = 0; jj < 8; ++jj) { const size_t ro = (size_t)(t0 + wave * 8 + jj) * ZLD + h * 64 + lane;
        unsigned v = Z[ro + Z_GK]; if (P3) v |= (unsigned)Z[ro + Z_GQ] << 16; g.kq[jj] = v; }
    if constexpr (!P3) {
        const f32x4* wp = (const f32x4*)((const float*)(p.ws + WS_WGT) + ((size_t)l * 256 + h * 64 + lane) * 16);
#pragma unroll
        for (int q = 0; q < 4; ++q) g.wup[q] = wp[q];
        g.bias = ((const float*)(p.ws + WS_SM))[l * 256 + h * 64 + lane];
    }
    if constexpr (P3) {
        const f32x4* SP = (const f32x4*)((const float*)(p.ws + WS_XB) + (size_t)item * 8192);
#pragma unroll
        for (int e = 0; e < 4; ++e) g.sp[e] = SP[tid + e * 512];
#pragma unroll
        for (int e = 0; e < 2; ++e) { const int cc = tid + e * 512; g.gt[e] = *(const u32x4*)(Z + (size_t)(t0 + (cc >> 4)) * ZLD + Z_GG + h * 128 + (cc & 15) * 8); }
        const int hf = wave >> 2, fr = lane & 15;
#pragma unroll
        for (int n = 0; n < 4; ++n) g.gn[n] = ((const float*)(p.ws + WS_SM))[1024 + l * 128 + hf * 64 + n * 16 + fr];
    }
}
template <bool P3> DI void gla_vt(const GlaIn<P3>& g, LAS unsigned char* lds, int lane, int wave) {
    { LAS bf16_t* VTt = (LAS bf16_t*)(lds + GL_VT);
#pragma unroll
      for (int e = 0; e < 2; ++e) { const int dv0 = (wave + 8 * e) * 8; const u32x4 w = g.vt[e];
          VTt[(dv0 + 0) * GS + lane] = (bf16_t)(w.x & 0xffffu); VTt[(dv0 + 1) * GS + lane] = (bf16_t)(w.x >> 16);
          VTt[(dv0 + 2) * GS + lane] = (bf16_t)(w.y & 0xffffu); VTt[(dv0 + 3) * GS + lane] = (bf16_t)(w.y >> 16);
          VTt[(dv0 + 4) * GS + lane] = (bf16_t)(w.z & 0xffffu); VTt[(dv0 + 5) * GS + lane] = (bf16_t)(w.z >> 16);
          VTt[(dv0 + 6) * GS + lane] = (bf16_t)(w.w & 0xffffu); VTt[(dv0 + 7) * GS + lane] = (bf16_t)(w.w >> 16); } }
}
DI void gla_front(const GlaIn<false>& g, LAS unsigned char* lds, int tid, int lane, int wave, float (&bv)[8], float& blast) {
    LAS float* LR = (LAS float*)(lds + GL_LR);
    LAS float* TOT = (LAS float*)(lds + GL_TOT);
    gla_vt<false>(g, lds, lane, wave);
#pragma unroll
    for (int e = 0; e < 2; ++e) LR[tid + e * 512] = bflo(g.lr[e]);
    __syncthreads();
    float run = 0.f;
#pragma unroll
    for (int jj = 0; jj < 8; ++jj) { const int j = wave * 8 + jj; float lg = g.bias;
#pragma unroll
        for (int q = 0; q < 4; ++q) { const f32x4 lv = *(const LAS f32x4*)(LR + j * 16 + q * 4); lg = fmaf(lv.x, g.wup[q].x, lg); lg = fmaf(lv.y, g.wup[q].y, lg); lg = fmaf(lv.z, g.wup[q].z, lg); lg = fmaf(lv.w, g.wup[q].w, lg); }
        run += logsigmoid16(lg); bv[jj] = run; }
    TOT[wave * 64 + lane] = run;
    __syncthreads();
    float off = 0.f, tot = 0.f;
#pragma unroll
    for (int s = 0; s < 8; ++s) { const float v = TOT[s * 64 + lane]; if (s < wave) off += v; tot += v; }
#pragma unroll
    for (int jj = 0; jj < 8; ++jj) bv[jj] += off;
    blast = tot;
}

DI void gla_compute1(const Params& p, int l, int item, const GlaIn<false>& g, LAS unsigned char* lds, int tid, int lane, int wave) {
    float* UPD = (float*)(p.ws + WS_XB); float* DEC = (float*)(p.ws + WS_DEC);
    float bv[8], blast;
    gla_front(g, lds, tid, lane, wave, bv, blast);
    {
        unsigned q[8];
#pragma unroll
        for (int jj = 0; jj < 8; ++jj) q[jj] = (unsigned)fminf(fmaf(-bv[jj], 4096.f, 0.5f), 65535.f);
        const u32x4 hw = {q[0] | (q[1] << 16), q[2] | (q[3] << 16), q[4] | (q[5] << 16), q[6] | (q[7] << 16)};
        *(u32x4*)((unsigned short*)(p.ws + WS_BC) + ((size_t)item * 64 + lane) * 64 + wave * 8) = hw;
    }
    {
        unsigned w[4];
#pragma unroll
        for (int q = 0; q < 4; ++q) w[q] = pk2(bflo(g.kq[2 * q]) * __expf(blast - bv[2 * q]), bflo(g.kq[2 * q + 1]) * __expf(blast - bv[2 * q + 1]));
        *(LAS u32x4*)(lds + GL_QD + lane * (2 * GS) + wave * 16) = (u32x4){w[0], w[1], w[2], w[3]};
        if (wave == 0) DEC[item * 64 + lane] = __expf(blast);
    }
    __syncthreads();
    const int fr = lane & 15, fq = lane >> 4;
    f32x4 acc[4];
#pragma unroll
    for (int n = 0; n < 4; ++n) acc[n] = (f32x4){0.f, 0.f, 0.f, 0.f};
#pragma unroll
    for (int ks = 0; ks < 2; ++ks) {
        const bf16x8 a = lds_frag(lds, GL_VT, wave * 16 + fr, ks * 32 + fq * 8);
#pragma unroll
        for (int n = 0; n < 4; ++n) { const bf16x8 b = lds_frag(lds, GL_QD, n * 16 + fr, ks * 32 + fq * 8); acc[n] = MFMA16(a, b, acc[n]); }
    }
    if (item >= 608) {
        if (tid == 0) { const unsigned* ctr = (const unsigned*)p.ws + CW_LATE + 64 * l; while (__hip_atomic_load(ctr, __ATOMIC_RELAXED, __HIP_MEMORY_SCOPE_AGENT) < 128u) __builtin_amdgcn_s_sleep(2); }
    }
    __syncthreads();
    LAS float* UT = (LAS float*)(lds + GL_UT);
#pragma unroll
    for (int n = 0; n < 4; ++n)
#pragma unroll
        for (int r = 0; r < 4; ++r) UT[(wave * 16 + fq * 4 + r) * 68 + n * 16 + fr] = acc[n][r];
    __syncthreads();
    f32x4* up = (f32x4*)(UPD + (size_t)item * 8192);
#pragma unroll
    for (int e = 0; e < 4; ++e) { const int cc = tid + e * 512; up[cc] = *(const LAS f32x4*)(UT + (cc >> 4) * 68 + (cc & 15) * 4); }
    __syncthreads();
}

DI void gla_compute3(const Params& p, int item, const GlaIn<true>& g, LAS unsigned char* lds, int tid, int lane, int wave) {
    const int c = item >> 2, h = item & 3, t0 = c * 64;
    bf16_t* OB = (bf16_t*)(p.ws + WS_KVR);
    float bv[8], blast;
#pragma unroll
    for (int e = 0; e < 4; ++e) { const int i4 = tid + e * 512; const f32x4 v = g.sp[e]; const int dv = i4 >> 4, k4 = (i4 & 15) * 4;
        *(LAS u32x2*)(lds + GL_SP + dv * (2 * GS) + k4 * 2) = (u32x2){pk2(v.x, v.y), pk2(v.z, v.w)}; }
#pragma unroll
    for (int e = 0; e < 2; ++e) { const int cc = tid + e * 512; LAS u32x2* gd_ = (LAS u32x2*)(lds + GL_GT + (cc >> 4) * 264 + (cc & 15) * 16); gd_[0] = (u32x2){g.gt[e].x, g.gt[e].y}; gd_[1] = (u32x2){g.gt[e].z, g.gt[e].w}; }
    gla_vt<true>(g, lds, lane, wave);
    {   const unsigned w4[4] = {g.bc.x, g.bc.y, g.bc.z, g.bc.w};
#pragma unroll
        for (int q = 0; q < 4; ++q) { bv[2 * q] = (float)(w4[q] & 0xffffu) * (-1.0f / 4096.f); bv[2 * q + 1] = (float)(w4[q] >> 16) * (-1.0f / 4096.f); }
        blast = 0.f; (void)blast; }
    {
        LAS bf16_t* QD = (LAS bf16_t*)(lds + GL_QD); LAS bf16_t* KI = (LAS bf16_t*)(lds + GL_KI);
#pragma unroll
        for (int jj = 0; jj < 8; ++jj) { const int j = wave * 8 + jj;
            const float q = bfhi(g.kq[jj]) * 0.125f * __expf(bv[jj]);
            const float k = bflo(g.kq[jj]) * __expf(-bv[jj]);
            QD[j * GS + lane] = f2bf(q); KI[j * GS + lane] = f2bf(k); }
    }
    __syncthreads();
    const int fr = lane & 15, fq = lane >> 4;
    {
        const int mt = wave >> 1, nb = (wave & 1) * 2;
        f32x4 a2[2] = {(f32x4){0.f, 0.f, 0.f, 0.f}, (f32x4){0.f, 0.f, 0.f, 0.f}};
#pragma unroll
        for (int ks = 0; ks < 2; ++ks) { const bf16x8 a = lds_frag(lds, GL_QD, mt * 16 + fr, ks * 32 + fq * 8);
#pragma unroll
            for (int n = 0; n < 2; ++n) { const bf16x8 b = lds_frag(lds, GL_KI, (nb + n) * 16 + fr, ks * 32 + fq * 8); a2[n] = MFMA16(a, b, a2[n]); } }
        LAS bf16_t* AT = (LAS bf16_t*)(lds + GL_AT);
#pragma unroll
        for (int n = 0; n < 2; ++n)
#pragma unroll
            for (int r = 0; r < 4; ++r) { const int i = mt * 16 + fq * 4 + r, j = (nb + n) * 16 + fr; AT[i * GS + j] = f2bf(j <= i ? a2[n][r] : 0.f); }
    }
    __syncthreads();
    const int mt = wave & 3, hf = wave >> 2;
    f32x4 acc[4];
#pragma unroll
    for (int n = 0; n < 4; ++n) acc[n] = (f32x4){0.f, 0.f, 0.f, 0.f};
#pragma unroll
    for (int ks = 0; ks < 2; ++ks) {
        const bf16x8 a1 = lds_frag(lds, GL_AT, mt * 16 + fr, ks * 32 + fq * 8);
        const bf16x8 a2 = lds_frag(lds, GL_QD, mt * 16 + fr, ks * 32 + fq * 8);
#pragma unroll
        for (int n = 0; n < 4; ++n) {
            const bf16x8 b1 = lds_frag(lds, GL_VT, hf * 64 + n * 16 + fr, ks * 32 + fq * 8);
            const bf16x8 b2 = lds_frag(lds, GL_SP, hf * 64 + n * 16 + fr, ks * 32 + fq * 8);
            acc[n] = MFMA16(a1, b1, acc[n]); acc[n] = MFMA16(a2, b2, acc[n]); }
    }
    LAS float* RS = (LAS float*)(lds + GL_RS);
    float ss[4];
#pragma unroll
    for (int r = 0; r < 4; ++r) { float s = 0.f;
#pragma unroll
        for (int n = 0; n < 4; ++n) s += acc[n][r] * acc[n][r];
        ss[r] = red16(s, lane); }
    if (fr == 0) {
#pragma unroll
        for (int r = 0; r < 4; ++r) RS[(mt * 16 + fq * 4 + r) * 2 + hf] = ss[r]; }
    __syncthreads();
    {
        const LAS bf16_t* GTt = (const LAS bf16_t*)(lds + GL_GT); LAS bf16_t* OTt = (LAS bf16_t*)(lds + GL_OT);
#pragma unroll
        for (int r = 0; r < 4; ++r) { const int i = mt * 16 + fq * 4 + r; const float rstd = rsqrtf((RS[i * 2] + RS[i * 2 + 1]) * (1.0f / 128.0f) + EPS);
#pragma unroll
            for (int n = 0; n < 4; ++n) { const int dv = hf * 64 + n * 16 + fr;
                const float gg = bf2f(GTt[i * 132 + dv]);
                OTt[i * 132 + dv] = f2bf(acc[n][r] * rstd * g.gn[n] * (gg / (1.f + __expf(-gg)))); } }
    }
    __syncthreads();
#pragma unroll
    for (int e = 0; e < 2; ++e) { const int cc = tid + e * 512;
        *(u32x4*)(OB + (size_t)(t0 + (cc >> 4)) * DM + h * 128 + (cc & 15) * 8) = __builtin_shufflevector(*(const LAS u32x2*)(lds + GL_OT + (cc >> 4) * 264 + (cc & 15) * 16), *(const LAS u32x2*)(lds + GL_OT + (cc >> 4) * 264 + (cc & 15) * 16 + 8), 0, 1, 2, 3); }
    __syncthreads();
}
template <bool P3> DI void gla_pass(const Params& p, int l, LAS unsigned char* lds, int tid, int lane, int wave, int first, int step, int nitems) {
    int it = first; if (it >= nitems) return;
    GlaIn<P3> cur; gla_load<P3>(p, l, it & 1023, tid, lane, wave, cur);
    for (;;) {
        const int nx = it + step; const bool has = nx < nitems;
        GlaIn<P3> nxt; gla_load<P3>(p, l, (has ? nx : it) & 1023, tid, lane, wave, nxt);
        if constexpr (P3) gla_compute3(p, it & 1023, cur, lds, tid, lane, wave); else gla_compute1(p, l, it & 1023, cur, lds, tid, lane, wave);
        if (!has) break;
        cur = nxt; it = nx;
    }
}

DI void gla_scan(const Params& p, int tid, LAS unsigned char* lds) {
    float* UPD = (float*)(p.ws + WS_XB); const float* DEC = (const float*)(p.ws + WS_DEC);
    LAS float* DL = (LAS float*)lds;
    for (int e0 = blockIdx.x * 512; e0 < 16 * 8192; e0 += gridDim.x * 512) {
        const int e = e0 + tid;
        const int bh = e >> 13, idx = e & 8191, k = idx & 63, b = bh >> 2, h = bh & 3;
        float* up0 = UPD + (size_t)((b * 64) << 2) * 8192 + (size_t)h * 8192 + idx; const float* dp0 = DEC + (((b * 64) << 2) + h) * 64;
#pragma unroll
        for (int q = 0; q < 8; ++q) { const int i = tid + q * 512; DL[i] = dp0[(i >> 6) * 4 * 64 + (i & 63)]; }
        __syncthreads();
        float S = 0.f;
#pragma unroll
        for (int n0 = 0; n0 < 64; n0 += 32) {
            float u[32];
#pragma unroll
            for (int n = 0; n < 32; ++n) u[n] = up0[(size_t)(n0 + n) * 4 * 8192];
#pragma unroll
            for (int n = 0; n < 32; ++n) { up0[(size_t)(n0 + n) * 4 * 8192] = S; S = fmaf(DL[(n0 + n) * 64 + k], S, u[n]); }
        }
        __syncthreads();
    }
}

constexpr float QSCALE = 0.07216878364870322f * 1.4426950408889634f;
DI void unpack8(const u32x4 w, float (&v)[8]) { v[0] = bflo(w.x); v[1] = bfhi(w.x); v[2] = bflo(w.y); v[3] = bfhi(w.y); v[4] = bflo(w.z); v[5] = bfhi(w.z); v[6] = bflo(w.w); v[7] = bfhi(w.w); }
DI void finalize_tile(const Params& p, int l, int tile, LAS unsigned char* lds, int tid, int lane, int wave, const bool doq = true) {
    unsigned char* ws = p.ws;
    const bf16_t* CQ = (const bf16_t*)(ws + WS_CQ); const bf16_t* MISC = (const bf16_t*)(ws + WS_MISC);
    bf16_t* QR = (bf16_t*)(ws + WS_QR); const bf16_t* KVR = (const bf16_t*)(ws + WS_KVR); bf16_t* KB = (bf16_t*)(ws + WS_K); bf16_t* VT = (bf16_t*)(ws + WS_VT);
    const float* COS = (const float*)(ws + WS_COS); const float* SIN = (const float*)(ws + WS_SIN);
    LAS bf16_t* VL = (LAS bf16_t*)lds;
    const int sub = lane >> 4, i = lane & 15;
    const int t0 = tile * 64;
    const float* qg = (const float*)(p.ws + WS_SM) + 1536 + l * 192; const float* kg = (const float*)(p.ws + WS_SM) + 2304 + l * 192;
#pragma unroll
    for (int it = 0; it < 2; ++it) {
        const int tl = wave * 8 + it * 4 + sub; const size_t t = (size_t)(t0 + tl);
        const u32x4 c0 = *(const u32x4*)(CQ + t * 256 + 16 * i), c1 = *(const u32x4*)(CQ + t * 256 + 16 * i + 8);
        const u32x4 kvw = *(const u32x4*)(MISC + t * 256 + 8 * i);
        const unsigned p1 = *(const unsigned*)(MISC + t * 256 + 128 + 2 * i), p2 = *(const unsigned*)(MISC + t * 256 + 160 + 2 * i);
        const f32x2 cs = *(const f32x2*)(COS + t * 32 + 2 * i), sn = *(const f32x2*)(SIN + t * 32 + 2 * i);
        float v[8], w[8]; float s1 = 0.f, s2 = 0.f;
        unpack8(c0, v); unpack8(c1, w);
#pragma unroll
        for (int e = 0; e < 8; ++e) s1 += v[e] * v[e] + w[e] * w[e];
        unpack8(kvw, v);
#pragma unroll
        for (int e = 0; e < 8; ++e) s2 += v[e] * v[e];
        const float x1a = bflo(p1), x1b = bfhi(p1), x2a = bflo(p2), x2b = bfhi(p2);
        float s3 = (x1a * x1a + x1b * x1b) + (x2a * x2a + x2b * x2b);
        s1 = red16(s1, lane); s2 = red16(s2, lane); s3 = red16(s3, lane);
        const float rcq = rsqrtf(s1 * (1.0f / 256.0f) + EPS), rckv = rsqrtf(s2 * (1.0f / 128.0f) + EPS);
        u32x4 qa4[4], ka4[4], va4[4]; unsigned r14[4], r24[4];
#pragma unroll
        for (int h = 0; h < 4; ++h) { const bf16_t* qp = QR + t * 768 + h * 192; const bf16_t* kp = KVR + t * 1024 + h * 256;
            qa4[h] = *(const u32x4*)(qp + 8 * i); r14[h] = *(const unsigned*)(qp + 128 + 2 * i); r24[h] = *(const unsigned*)(qp + 160 + 2 * i);
            ka4[h] = *(const u32x4*)(kp + 8 * i); va4[h] = *(const u32x4*)(kp + 128 + 8 * i); }
        const f32x4 qg0 = *(const f32x4*)(qg + 8 * i), qg1 = *(const f32x4*)(qg + 8 * i + 4), kg0 = *(const f32x4*)(kg + 8 * i), kg1 = *(const f32x4*)(kg + 8 * i + 4);
        const f32x2 qgr1 = *(const f32x2*)(qg + 128 + 2 * i), qgr2 = *(const f32x2*)(qg + 160 + 2 * i), kgr1 = *(const f32x2*)(kg + 128 + 2 * i), kgr2 = *(const f32x2*)(kg + 160 + 2 * i);
        if (doq)
#pragma unroll
        for (int h = 0; h < 4; ++h) {
            bf16_t* qp = QR + t * 768 + h * 192;
            const u32x4 qa = qa4[h]; const unsigned r1 = r14[h], r2 = r24[h];
            unpack8(qa, v);
            const float y1a = bflo(r1) * rcq, y1b = bfhi(r1) * rcq, y2a = bflo(r2) * rcq, y2b = bfhi(r2) * rcq;
            float ss = (y1a * y1a + y1b * y1b) + (y2a * y2a + y2b * y2b);
#pragma unroll
            for (int e = 0; e < 8; ++e) { v[e] *= rcq; ss += v[e] * v[e]; }
            ss = red16(ss, lane);
            const float rq = rsqrtf(ss * (1.0f / 192.0f) + EPS) * QSCALE;
            const f32x4 g0 = qg0, g1 = qg1; const f32x2 gr1 = qgr1, gr2 = qgr2;
            u32x4 o; o.x = pk2(v[0] * rq * g0.x, v[1] * rq * g0.y); o.y = pk2(v[2] * rq * g0.z, v[3] * rq * g0.w); o.z = pk2(v[4] * rq * g1.x, v[5] * rq * g1.y); o.w = pk2(v[6] * rq * g1.z, v[7] * rq * g1.w);
            *(u32x4*)(qp + 8 * i) = o;
            const float a1 = y1a * rq * gr1.x, b1 = y1b * rq * gr1.y, a2 = y2a * rq * gr2.x, b2 = y2b * rq * gr2.y;
            *(unsigned*)(qp + 128 + 2 * i) = pk2(a1 * cs.x - a2 * sn.x, b1 * cs.y - b2 * sn.y);
            *(unsigned*)(qp + 160 + 2 * i) = pk2(a1 * sn.x + a2 * cs.x, b1 * sn.y + b2 * cs.y);
        }
#pragma unroll
        for (int h = 0; h < 4; ++h) {
            const u32x4 ka = ka4[h], va = va4[h];
            unpack8(ka, v);
            float ss = 0.f;
#pragma unroll
            for (int e = 0; e < 8; ++e) { v[e] *= rckv; ss += v[e] * v[e]; }
            ss = red16(ss, lane) + s3;
            const float rk = rsqrtf(ss * (1.0f / 192.0f) + EPS);
            const f32x4 g0 = kg0, g1 = kg1; const f32x2 gr1 = kgr1, gr2 = kgr2;
            bf16_t* ko = KB + t * 768 + h * 192;
            u32x4 o; o.x = pk2(v[0] * rk * g0.x, v[1] * rk * g0.y); o.y = pk2(v[2] * rk * g0.z, v[3] * rk * g0.w); o.z = pk2(v[4] * rk * g1.x, v[5] * rk * g1.y); o.w = pk2(v[6] * rk * g1.z, v[7] * rk * g1.w);
            *(u32x4*)(ko + 8 * i) = o;
            const float a1 = x1a * rk * gr1.x, b1 = x1b * rk * gr1.y, a2 = x2a * rk * gr2.x, b2 = x2b * rk * gr2.y;
            *(unsigned*)(ko + 128 + 2 * i) = pk2(a1 * cs.x - a2 * sn.x, b1 * cs.y - b2 * sn.y);
            *(unsigned*)(ko + 160 + 2 * i) = pk2(a1 * sn.x + a2 * cs.x, b1 * sn.y + b2 * cs.y);
            unpack8(va, w);
            u32x4 vo; vo.x = pk2(w[0] * rckv, w[1] * rckv); vo.y = pk2(w[2] * rckv, w[3] * rckv); vo.z = pk2(w[4] * rckv, w[5] * rckv); vo.w = pk2(w[6] * rckv, w[7] * rckv);
            *(LAS u32x4*)(VL + tl * 512 + h * 128 + 8 * i) = vo;
        }
    }
    __syncthreads();
    {
        const int b = t0 >> 12, s0 = t0 & 4095, h = tid >> 7, dv = tid & 127;
        bf16_t* dst = VT + ((size_t)((b * 4 + h) * 128 + dv)) * SEQ + s0;
#pragma unroll
        for (int q = 0; q < 8; ++q) { unsigned wv[4];
#pragma unroll
            for (int e = 0; e < 4; ++e) wv[e] = (unsigned)VL[(q * 8 + 2 * e) * 512 + tid] | ((unsigned)VL[(q * 8 + 2 * e + 1) * 512 + tid] << 16);
            *(u32x4*)(dst + q * 8) = (u32x4){wv[0], wv[1], wv[2], wv[3]}; }
    }
    __syncthreads();
}

constexpr int AT_KB = 25600, AT_VB = 17408, AT_K0 = 0, AT_V0 = 2 * AT_KB, AT_MB = 0;
DI void attn_unit(const Params& p, int b, int h, int qb, LAS unsigned char* lds, int tid, int lane, int wave) {
    unsigned char* ws = p.ws;
    const bf16_t* Q = (const bf16_t*)(ws + WS_QR); const bf16_t* KB = (const bf16_t*)(ws + WS_K); const bf16_t* VT = (const bf16_t*)(ws + WS_VT);
    const bf16_t* Z = (const bf16_t*)(ws + WS_Z); bf16_t* OB = (bf16_t*)(ws + WS_KVR);
    const int g = wave >> 2, w4 = wave & 3, r = lane & 31, hh = lane >> 5;
    const int qr0 = qb * 128 + w4 * 32, nst = 2 * (qb + 1);
    const size_t tokb = (size_t)b * SEQ;
    bf16x8 qf[12];
    { const bf16_t* qp = Q + (tokb + qr0 + r) * 768 + h * 192 + 8 * hh;
#pragma unroll
      for (int kk = 0; kk < 12; ++kk) qf[kk] = *(const bf16x8*)(qp + 16 * kk); }
    f32x16 o[4];
#pragma unroll
    for (int i = 0; i < 4; ++i)
#pragma unroll
        for (int j = 0; j < 16; ++j) o[i][j] = 0.f;
    float mrow = -INFINITY, lrow = 0.f;
    const bf16_t* kbase = KB + tokb * 768 + h * 192;
    const bf16_t* vbase = VT + (size_t)((b * 4 + h) * 128) * SEQ;
    int krow[3], kcol[3];
#pragma unroll
    for (int e = 0; e < 3; ++e) { const int c = tid + 512 * e; krow[e] = c / 24; kcol[e] = c % 24; }
    u32x4 pk[3], pv[2];
#define AT_LOAD(st) do { _Pragma("unroll") for (int e = 0; e < 3; ++e) pk[e] = *(const u32x4*)(kbase + (size_t)((st) * 64 + krow[e]) * 768 + kcol[e] * 8); \
        _Pragma("unroll") for (int e = 0; e < 2; ++e) { const int c = tid + 512 * e; pv[e] = *(const u32x4*)(vbase + (size_t)(c >> 3) * SEQ + (st) * 64 + (c & 7) * 8); } } while (0)
#define AT_WRITE(buf) do { _Pragma("unroll") for (int e = 0; e < 3; ++e) *(LAS u32x4*)(lds + AT_K0 + (buf) * AT_KB + krow[e] * 400 + kcol[e] * 16) = pk[e]; \
        _Pragma("unroll") for (int e = 0; e < 2; ++e) { const int c = tid + 512 * e; LAS u32x2* vd_ = (LAS u32x2*)(lds + AT_V0 + (buf) * AT_VB + (c >> 3) * 136 + (c & 7) * 16); vd_[0] = (u32x2){pv[e].x, pv[e].y}; vd_[1] = (u32x2){pv[e].z, pv[e].w}; } } while (0)
    AT_LOAD(0); AT_WRITE(0);
    __syncthreads();
    for (int st = 0; st < nst; ++st) {
        const int buf = st & 1;
        if (st + 1 < nst) AT_LOAD(st + 1);
        const int kb = st * 64 + g * 32;
        if (kb <= qr0 + 31) {
            f32x16 s;
#pragma unroll
            for (int j = 0; j < 16; ++j) s[j] = 0.f;
            const LAS unsigned char* kp = lds + AT_K0 + buf * AT_KB + (g * 32 + r) * 400 + hh * 16;
            bf16x8 kf[12];
#pragma unroll
            for (int kk = 0; kk < 12; ++kk) kf[kk] = *(const LAS bf16x8*)(kp + kk * 32);
            __builtin_amdgcn_sched_barrier(0);
            __builtin_amdgcn_s_setprio(1);
#pragma unroll
            for (int kk = 0; kk < 12; ++kk) s = MFMA32(kf[kk], qf[kk], s);
            __builtin_amdgcn_s_setprio(0);
            const LAS unsigned char* vp = lds + AT_V0 + buf * AT_VB + r * 136 + (g * 32 + 4 * hh) * 2;
            bf16x8 vf[2][4];
#pragma unroll
            for (int ks = 0; ks < 2; ++ks)
#pragma unroll
                for (int blk = 0; blk < 4; ++blk) {
                    const s16x4 lo = *(const LAS s16x4*)(vp + blk * 32 * 136 + ks * 32), hi = *(const LAS s16x4*)(vp + blk * 32 * 136 + ks * 32 + 16);
                    vf[ks][blk] = __builtin_shufflevector(lo, hi, 0, 1, 2, 3, 4, 5, 6, 7);
                }
            __builtin_amdgcn_sched_barrier(0);
            if (kb + 31 > qr0) {
                const int qa = qr0 + r - kb - 4 * hh;
#pragma unroll
                for (int j = 0; j < 16; ++j) if ((j & 3) + 8 * (j >> 2) > qa) s[j] = -INFINITY;
            }
            float mx = fmaxf(fmaxf(fmaxf(s[0], s[1]), fmaxf(s[2], s[3])), fmaxf(fmaxf(s[4], s[5]), fmaxf(s[6], s[7])));
            mx = fmaxf(mx, fmaxf(fmaxf(fmaxf(s[8], s[9]), fmaxf(s[10], s[11])), fmaxf(fmaxf(s[12], s[13]), fmaxf(s[14], s[15]))));
            { const u32x2 sw = __builtin_amdgcn_permlane32_swap(__float_as_uint(mx), __float_as_uint(mx), false, false);
              mx = fmaxf(__uint_as_float(sw.x), __uint_as_float(sw.y)); }
            if (__builtin_amdgcn_ballot_w64(mx > mrow + 8.0f) != 0ull) {
                const float mnew = fmaxf(mrow, mx);
                const float alpha = (mnew == -INFINITY) ? 1.0f : __builtin_amdgcn_exp2f(mrow - mnew);
                mrow = mnew; lrow *= alpha;
#pragma unroll
                for (int i = 0; i < 4; ++i)
#pragma unroll
                    for (int j = 0; j < 16; ++j) o[i][j] *= alpha;
            }
            const float muse = (mrow == -INFINITY) ? 0.f : mrow;
            float ps = 0.f;
#pragma unroll
            for (int j = 0; j < 16; ++j) { s[j] = __builtin_amdgcn_exp2f(s[j] - muse); ps += s[j]; }
            lrow += ps;
#pragma unroll
            for (int ks = 0; ks < 2; ++ks) {
                u32x4 pw; pw.x = pk2(s[8 * ks], s[8 * ks + 1]); pw.y = pk2(s[8 * ks + 2], s[8 * ks + 3]); pw.z = pk2(s[8 * ks + 4], s[8 * ks + 5]); pw.w = pk2(s[8 * ks + 6], s[8 * ks + 7]);
                const bf16x8 pf = __builtin_bit_cast(bf16x8, pw);
                __builtin_amdgcn_s_setprio(1);
#pragma unroll
                for (int blk = 0; blk < 4; ++blk) o[blk] = MFMA32(vf[ks][blk], pf, o[blk]);
                __builtin_amdgcn_s_setprio(0);
            }
        }
        if (st + 1 < nst) AT_WRITE(buf ^ 1);
        __syncthreads();
    }
#undef AT_LOAD
#undef AT_WRITE
    lrow += shx(lrow, 32, lane);
    LAS float* MB = (LAS float*)(lds + AT_MB) + w4 * 66 * 64 + lane;
    if (g == 1) {
#pragma unroll
        for (int i = 0; i < 4; ++i)
#pragma unroll
            for (int j = 0; j < 16; ++j) MB[(i * 16 + j) * 64] = o[i][j];
        MB[64 * 64] = mrow; MB[65 * 64] = lrow;
    }
    __syncthreads();
    if (g == 0) {
        const float m1 = MB[64 * 64], l1 = MB[65 * 64];
        const float m = fmaxf(mrow, m1);
        const float a0 = __builtin_amdgcn_exp2f(mrow - m), a1 = __builtin_amdgcn_exp2f(m1 - m);
        const float inv = 1.0f / (lrow * a0 + l1 * a1);
        const size_t tok = tokb + qr0 + r;
        const bf16_t* gp = Z + tok * ZLD + Z_MG + h * 128 + 4 * hh;
        bf16_t* op = OB + tok * DM + 512 + h * 128 + 4 * hh;
        u32x2 gw[4][4];
#pragma unroll
        for (int i = 0; i < 4; ++i)
#pragma unroll
            for (int q = 0; q < 4; ++q) gw[i][q] = *(const u32x2*)(gp + i * 32 + q * 8);
#pragma unroll
        for (int i = 0; i < 4; ++i)
#pragma unroll
            for (int q = 0; q < 4; ++q) {
                float gv[4] = {bflo(gw[i][q].x), bfhi(gw[i][q].x), bflo(gw[i][q].y), bfhi(gw[i][q].y)}; float ov[4];
#pragma unroll
                for (int e = 0; e < 4; ++e) { const float val = (o[i][q * 4 + e] * a0 + MB[(i * 16 + q * 4 + e) * 64] * a1) * inv; ov[e] = val * (gv[e] / (1.f + __expf(-gv[e]))); }
                *(u32x2*)(op + i * 32 + q * 8) = (u32x2){pk2(ov[0], ov[1]), pk2(ov[2], ov[3])};
            }
    }
    __syncthreads();
}


#define XB_TMO      128
#define XB_XCNT(j)  (256  + 64 * (j))
#define XB_XSUB(j)  (1280 + 64 * (j))
#define XB_XGEN(j)  (2304 + 64 * (j))
#define XB_TOP      3328
#define XB_TOPGEN   3392
#define XCD_BAR_WORDS 3456
#define XB_SPIN_CAP (1u << 18)
DI unsigned xb_ld(unsigned* p)              { return __hip_atomic_load(p, __ATOMIC_RELAXED, __HIP_MEMORY_SCOPE_AGENT); }
DI unsigned xb_add(unsigned* p, unsigned v) { return __hip_atomic_fetch_add(p, v, __ATOMIC_RELAXED, __HIP_MEMORY_SCOPE_AGENT); }
DI unsigned xb_xcc_id() { return (unsigned)__builtin_amdgcn_s_getreg((3 << 11) | 20) & 0xFu; }
#define XB_SPIN(cond, bar) do { unsigned _sp = 0; while (cond) { __builtin_amdgcn_s_sleep(1); \
    if ((++_sp & 255u) == 0u) { if (xb_ld(&(bar)[XB_TMO])) break; if (_sp > XB_SPIN_CAP) { atomicAdd(&(bar)[XB_TMO], 1u); break; } } } } while (0)
struct XcdBarrier { unsigned* bar; unsigned x; volatile LAS unsigned* st; };
DI XcdBarrier xcd_barrier_post(unsigned* bar, volatile LAS unsigned* st) {
    XcdBarrier b; b.bar = bar; b.x = xb_xcc_id(); b.st = st;
    if (threadIdx.x == 0) (void)xb_add(&bar[XB_XCNT(b.x)], 1u);
    return b;
}
DI void xcd_barrier_complete(unsigned* bar, unsigned x, unsigned& nloc, unsigned& nx) {
    const unsigned G = gridDim.x * gridDim.y * gridDim.z;
    unsigned sum, cnt, mine, sp = 0u;
    for (;;) {
        sum = 0u; cnt = 0u; mine = 0u;
#pragma unroll
        for (unsigned j = 0; j < 16; ++j) { const unsigned c = xb_ld(&bar[XB_XCNT(j)]); sum += c; cnt += (c > 0u) ? 1u : 0u; mine = (j == x) ? c : mine; }
        if (sum == G) break;
        __builtin_amdgcn_s_sleep(1);
        if ((++sp & 255u) == 0u) { if (xb_ld(&bar[XB_TMO])) break; if (sp > XB_SPIN_CAP) { atomicAdd(&bar[XB_TMO], 1u); break; } }
    }
    nloc = mine > 0u ? mine : 1u; nx = cnt > 0u ? cnt : 1u;
}
DI void xcd_barrier(unsigned* bar_, LAS unsigned char* lds_) {
    XcdBarrier b; b.bar = bar_; b.x = xb_xcc_id(); b.st = (volatile LAS unsigned*)(lds_ + LDS_BYTES - 64);
    asm volatile("s_waitcnt vmcnt(0)" ::: "memory");
    __syncthreads();
    if (threadIdx.x == 0) {
        unsigned* bar = b.bar;
        __builtin_amdgcn_s_waitcnt(0);
        unsigned nloc = b.st[0], nx = b.st[1];
        if (nloc == 0u) { xcd_barrier_complete(bar, b.x, nloc, nx); b.st[0] = nloc; b.st[1] = nx; }
        const unsigned old = xb_add(&bar[XB_XSUB(b.x)], 1u);
        const unsigned gen = old / nloc;
        if (old + 1u == (gen + 1u) * nloc) {
            __builtin_amdgcn_fence(__ATOMIC_RELEASE, "agent");
            asm volatile("s_waitcnt vmcnt(0)" ::: "memory");
            const unsigned og = xb_add(&bar[XB_TOP], 1u);
            const unsigned tg = og / nx;
            if (og + 1u == (tg + 1u) * nx) xb_add(&bar[XB_TOPGEN], 1u);
            else XB_SPIN(xb_ld(&bar[XB_TOPGEN]) == tg, bar);
            __builtin_amdgcn_fence(__ATOMIC_ACQUIRE, "agent");
            xb_add(&bar[XB_XGEN(b.x)], 1u);
            asm volatile("s_waitcnt vmcnt(0)" ::: "memory");
        } else {
            XB_SPIN(xb_ld(&bar[XB_XGEN(b.x)]) == gen, bar);
            __builtin_amdgcn_fence(__ATOMIC_ACQUIRE, "agent");
            asm volatile("s_waitcnt vmcnt(0)" ::: "memory");
        }
    }
    __syncthreads();
}

#define FRESH() const int lane = fresh_lane(); int wave = wave_s; asm volatile("" : "+s"(wave)); const int tid = wave * 64 + lane; (void)tid; unsigned char* ws = p.ws; asm volatile("" : "+s"(ws)); (void)ws; Params pl = p; pl.ws = ws; (void)pl
__global__ void __launch_bounds__(512, 2) hymba_fwd(Params p) {
    extern __shared__ __attribute__((aligned(16))) unsigned char lds_raw[];
    LAS unsigned char* lds = (LAS unsigned char*)lds_raw;
    cg::grid_group grid = cg::this_grid();
    if (threadIdx.x < 2) ((volatile LAS unsigned*)(lds + LDS_BYTES - 64))[threadIdx.x] = 0u;
    __syncthreads();
    (void)xcd_barrier_post((unsigned*)p.ws, (volatile LAS unsigned*)(lds + LDS_BYTES - 64));
    const int wave_s = __builtin_amdgcn_readfirstlane(threadIdx.x >> 6);
    const int G = gridDim.x, bx = blockIdx.x;
    const int vcu = (G % 8 == 0) ? (bx % 8) * (G / 8) + bx / 8 : bx;

#ifndef PHMASK
#define PHMASK 0xffff
#endif
#ifndef DUPMASK
#define DUPMASK 0
#endif
#if PHMASK & 1
    for (int rep = 0; rep < ((DUPMASK & 1) ? 2 : 1); ++rep) { FRESH(); p0_prologue(pl, lds, tid, lane, wave); __syncthreads(); }
#endif
    xcd_barrier((unsigned*)p.ws, lds);
    if (gridDim.x == 0x7fffffffu) grid.sync();

    for (int l = 0; l < DEPTH; ++l) {
        for (int ph = 0; ph < 2; ++ph) {
#if PHMASK & 2
            { FRESH(); float* SSQ = (float*)(ws + WS_SSQ);
                pg8::Gemm g{(const bf16_t*)(ws + WS_XB), (const bf16_t*)(ws + WS_WIN) + (size_t)l * N1 * DM, T, N1, DM};
                pg8::StaticOrder S; if (ph == 0) S.init_in(vcu, G, 512); else if (G == 256) S.init_in((vcu & 1) ? 640 : 512 + (vcu >> 1), 640, 640); else S.init_in(512 + vcu, G, 640);
                EpiZ E{(bf16_t*)(ws + WS_Z), (bf16_t*)(ws + WS_CQ), (bf16_t*)(ws + WS_MISC), SSQ};
                pg8::gemm_phase<EpiZ, true, (DUPMASK & 4096) != 0>(lds, g, S, E, tid);
                __syncthreads();
                if (ph == 1) {
                    const int nmine = (G == 256) ? ((vcu & 1) ? 0 : 1) : ((vcu < 128) ? (128 - vcu + G - 1) / G : 0);
                    if (nmine > 0 && threadIdx.x == 0) __hip_atomic_fetch_add((unsigned*)p.ws + CW_LATE + 64 * l, (unsigned)nmine, __ATOMIC_RELAXED, __HIP_MEMORY_SCOPE_AGENT);
                }
            }
#endif
            if (ph == 0) {
                xcd_barrier((unsigned*)p.ws, lds);
#if DUPMASK & 512
                xcd_barrier((unsigned*)p.ws, lds);
#endif
            }
        }
        const bool bal = (G == 256);
        const bool heavy = bal && !(vcu & 1);
        const int hv = vcu >> 1;
#if PHMASK & 4
        { FRESH();
            pg8::Gemm g{(const bf16_t*)(ws + WS_CQ), (const bf16_t*)(ws + WS_WUP) + (size_t)l * WUP_ROWS * 256, 2 * T, WUP_ROWS, 256};
            pg8::StaticOrder S;
            if (!bal) S.init_up(vcu, G, 448); else if (heavy) S.init_up(hv, 448, 448); else S.init_up(128 + hv, 128, 448);
            EpiUp E{(bf16_t*)(ws + WS_QR), (bf16_t*)(ws + WS_KVR)};
            pg8::gemm_phase<EpiUp>(lds, g, S, E, tid);
        }
        __syncthreads();
#endif
#if PHMASK & 8
        { FRESH();
            int first, step, lim;
            if (!bal) { first = vcu; step = G; lim = 1024; } else if (heavy) { first = 640 + hv * 3; step = 1; lim = first + 3; } else { first = hv * 5; step = 1; lim = first + 5; }
            gla_pass<false>(p, l, lds, tid, lane, wave, first, step, lim); }
#endif
        xcd_barrier((unsigned*)p.ws, lds);
#if DUPMASK & 512
        xcd_barrier((unsigned*)p.ws, lds);
#endif
#if PHMASK & 16
        for (int it = bx; it < 256; it += G) { FRESH(); finalize_tile(pl, l, it, lds, tid, lane, wave); }
#if DUPMASK & 16
        for (int it = bx; it < 256; it += G) { FRESH(); finalize_tile(pl, l, it, lds, tid, lane, wave, false); }
#endif
#endif
#if PHMASK & 32
        { FRESH(); gla_scan(pl, tid, lds); }
#endif
        xcd_barrier((unsigned*)p.ws, lds);
#if DUPMASK & 512
        xcd_barrier((unsigned*)p.ws, lds);
#endif
#if PHMASK & 64
        for (int pr = vcu; pr < ((DUPMASK & 64) ? 512 : 256); pr += G) {
            const int bh = (pr >> 4) & 15, i = pr & 15;
            { FRESH(); attn_unit(p, bh >> 2, bh & 3, 31 - i, lds, tid, lane, wave); }
            { FRESH(); attn_unit(p, bh >> 2, bh & 3, i, lds, tid, lane, wave); }
        }
#endif
#if PHMASK & 128
        { FRESH(); gla_pass<true>(p, l, lds, tid, lane, wave, bx, G, (DUPMASK & 128) ? 2048 : 1024); }
#endif
        xcd_barrier((unsigned*)p.ws, lds);
#if DUPMASK & 512
        xcd_barrier((unsigned*)p.ws, lds);
#endif
#if PHMASK & 256
        for (int rep = 0; rep < (((DUPMASK & 256) && l == 0) ? 2 : 1); ++rep) { FRESH(); float* SSQ = (float*)(ws + WS_SSQ);
            pg8::Gemm g{(const bf16_t*)(ws + WS_KVR), (const bf16_t*)(ws + WS_WOUT) + (size_t)l * DM * DM, T, DM, DM};
            pg8::StaticOrder S; S.init(T, DM, G, bx);
            const bool lastl = (l == DEPTH - 1);
            EpiOut E{l == 0 ? p.x : p.out, p.out, lastl ? nullptr : (bf16_t*)(ws + WS_XB), lastl ? nullptr : SSQ};
            pg8::gemm_phase<EpiOut, false, (DUPMASK & 2048) != 0>(lds, g, S, E, tid);
            __syncthreads();
        }
#endif
        if (l + 1 < DEPTH) xcd_barrier((unsigned*)p.ws, lds);
    }
}


extern "C" void kernel_launch(void* const* d_in, const int* in_sizes, int n_in, void* d_out, int out_size, void* d_ws, size_t ws_size, hipStream_t stream) {
    static int grid = 0;
    if (grid == 0) {
        if (n_in != 14 || ws_size < WS_END) { fprintf(stderr, "kernel_launch: unexpected inputs (n_in %d, ws %zu)\n", n_in, ws_size); grid = -1; return; }
        int dev = 0, cus = 0, per_cu = 0;
        hipGetDevice(&dev);
        hipDeviceGetAttribute(&cus, hipDeviceAttributeMultiprocessorCount, dev);
        if (hipFuncSetAttribute((const void*)hymba_fwd, hipFuncAttributeMaxDynamicSharedMemorySize, LDS_BYTES) != hipSuccess) { fprintf(stderr, "kernel_launch: hipFuncSetAttribute failed\n"); grid = -1; return; }
        if (hipOccupancyMaxActiveBlocksPerMultiprocessor(&per_cu, (const void*)hymba_fwd, 512, LDS_BYTES) != hipSuccess || per_cu < 1) { fprintf(stderr, "kernel_launch: occupancy query gave %d\n", per_cu); per_cu = 1; }
        (void)hipGetLastError();
        grid = cus * per_cu;
        if (grid > 256) grid = 256;
    }
    if (grid < 0) return;
    Params p{};
    p.x = (const float*)d_in[0]; p.pos = (const int*)d_in[1]; p.norm_g = (const float*)d_in[2]; p.w_in = (const float*)d_in[3];
    p.w_gate_up = (const float*)d_in[4]; p.b_gate = (const float*)d_in[5]; p.gla_norm_g = (const float*)d_in[6]; p.q_norm_g = (const float*)d_in[7];
    p.w_uq = (const float*)d_in[8]; p.kv_norm_g = (const float*)d_in[9]; p.w_ukv = (const float*)d_in[10]; p.q_head_g = (const float*)d_in[11];
    p.k_head_g = (const float*)d_in[12]; p.w_out = (const float*)d_in[13];
    p.out = (float*)d_out; p.ws = (unsigned char*)d_ws;
    if (hipMemsetAsync(d_ws, 0, 65536, stream) != hipSuccess) { fprintf(stderr, "kernel_launch: memset failed\n"); return; }
    void* args[] = {&p};
    hipError_t e = hipLaunchCooperativeKernel((const void*)hymba_fwd, dim3(grid), dim3(512), args, LDS_BYTES, stream);
    if (e != hipSuccess) fprintf(stderr, "cooperative launch failed: %s (grid %d)\n", hipGetErrorString(e), grid);
}
```

```cpp
#include <hip/hip_runtime.h>
#include <hip/hip_cooperative_groups.h>
#include <cstdio>
#include <cstdint>
namespace cg = cooperative_groups;

#define DI __device__ __forceinline__
#define LAS __attribute__((address_space(3)))
typedef unsigned short bf16_t;
typedef short bf16x8 __attribute__((ext_vector_type(8)));
typedef short s16x4 __attribute__((ext_vector_type(4)));
typedef float f32x4 __attribute__((ext_vector_type(4)));
typedef float f32x16 __attribute__((ext_vector_type(16)));
typedef float f32x2 __attribute__((ext_vector_type(2)));
typedef unsigned u32x4 __attribute__((ext_vector_type(4)));
typedef unsigned u32x2 __attribute__((ext_vector_type(2)));
typedef __bf16 bf2_t __attribute__((ext_vector_type(2)));

DI unsigned pk2(float lo, float hi) { f32x2 v = {lo, hi}; return __builtin_bit_cast(unsigned, __builtin_convertvector(v, bf2_t)); }
DI bf16_t f2bf(float f) { return (bf16_t)(pk2(f, 0.f) & 0xffffu); }
DI float bf2f(bf16_t b) { return __uint_as_float((unsigned)b << 16); }
DI float bflo(unsigned w) { return __uint_as_float(w << 16); }
DI float bfhi(unsigned w) { return __uint_as_float(w & 0xffff0000u); }
DI int fresh_lane() { int l; asm volatile("v_mbcnt_lo_u32_b32 %0, -1, 0\n\tv_mbcnt_hi_u32_b32 %0, -1, %0" : "=v"(l)); return l; }
DI float shx(float v, int m, int lane) { return __int_as_float(__builtin_amdgcn_ds_bpermute((lane ^ m) << 2, __float_as_int(v))); }
#define DPP_ROR(v, n) __int_as_float(__builtin_amdgcn_update_dpp(0, __float_as_int(v), 0x120 + (n), 0xf, 0xf, false))
DI float red16(float v, int lane) { (void)lane; v += DPP_ROR(v, 1); v += DPP_ROR(v, 2); v += DPP_ROR(v, 4); v += DPP_ROR(v, 8); return v; }
DI float wave_sum(float v, int lane) {
    v = red16(v, lane);
    const int iv = __float_as_int(v);
    return (__int_as_float(__builtin_amdgcn_readlane(iv, 0)) + __int_as_float(__builtin_amdgcn_readlane(iv, 16))) + (__int_as_float(__builtin_amdgcn_readlane(iv, 32)) + __int_as_float(__builtin_amdgcn_readlane(iv, 48)));
}

constexpr int T = 16384, SEQ = 4096, DM = 1024, DEPTH = 4, DIN = 2512, N1 = 2560;
constexpr float EPS = 1e-6f;
constexpr int ZLD = 2048;
constexpr int Z_GQ = 0, Z_GK = 256, Z_GV = 512, Z_GG = 1024, Z_MG = 1536;

constexpr size_t MiB = 1u << 20;
constexpr size_t WS_WIN = 1 * MiB;
constexpr size_t WS_WOUT = 21 * MiB;
constexpr size_t WS_WUP = 29 * MiB;
constexpr int WUP_ROWS = 1792;
constexpr size_t WS_WGT = 128 * 1024;
constexpr size_t WS_SM = 192 * 1024;
constexpr size_t WS_COS = 33 * MiB;
constexpr size_t WS_SIN = 35 * MiB;
constexpr size_t WS_SSQ = 37 * MiB;
constexpr size_t WS_XB = 38 * MiB;
constexpr size_t WS_Z = 70 * MiB;
constexpr size_t WS_CQ = 134 * MiB;
constexpr size_t WS_MISC = 142 * MiB;
constexpr size_t WS_QR = 150 * MiB;
constexpr size_t WS_KVR = 174 * MiB;
constexpr size_t WS_K = 206 * MiB;
constexpr size_t WS_VT = 230 * MiB;
constexpr size_t WS_DEC = 246 * MiB;
constexpr size_t WS_BC = 247 * MiB;
constexpr size_t WS_END = 255 * MiB;

constexpr int CW_LATE = 8192;
constexpr int LDS_BYTES = 147456;

namespace pg8 {
constexpr int BM = 256, BK = 64, HALF = 128, HTB = HALF * BK * 2, STAGE_BYTES = 8 * HTB, NXCD = 8, WGM = 8;
__host__ __device__ __forceinline__ int lds_byte(int r, int c) { const int st = (r >> 4) * 2 + (c >> 5), rr = r & 15, cc = c & 31, ob = rr * 64 + cc * 2; return st * 1024 + (ob ^ (((ob >> 9) & 1) << 5)); }
__host__ __device__ __forceinline__ void stage_rc(int b, int& R, int& C) { const int st = b / 1024, sb = b % 1024, swz = sb ^ (((sb >> 9) & 1) << 5); R = (st >> 1) * 16 + swz / 64; C = (st & 1) * 32 + (swz % 64) / 2; }
__host__ __device__ __forceinline__ int perm32(int rho) { const int n = rho >> 4, i = rho & 15; return 8 * (i >> 2) + 4 * n + (i & 3); }
struct Unit { int pm, pn; };
struct Gemm { const bf16_t* A; const bf16_t* Bt; int M, N, K; };
struct StaticOrder {
    int nM, nN, nwg, G, c, mode, lim;
    __device__ void init(int M, int N, int G_, int c_) { nM = M / BM; nN = N / BM; nwg = nM * nN; G = G_; c = c_; mode = 0; lim = nwg; }
    __device__ void init_up(int first, int stride, int lim_) { c = first; G = stride; lim = lim_; mode = 1; nM = 128; nN = 7; nwg = 448; }
    __device__ void init_in(int first, int stride, int lim_) { c = first; G = stride; lim = lim_; mode = 2; nM = 64; nN = 10; nwg = 640; }
    __device__ bool next(int i, Unit& u) const {
        const long L = (long)i * G + c; if (L >= lim) return false;
        if (mode == 1) { const int x = (int)L; if (x < 256) { u.pm = 64 + (x >> 2); u.pn = 3 + (x & 3); } else { const int y = x - 256; u.pm = y / 3; u.pn = y - 3 * u.pm; } return true; }
        if (mode == 2) { int x = (int)L; const bool late = x >= 320; if (late) x -= 320; u.pm = x / 5; const int t5 = x - 5 * u.pm;
            u.pn = late ? (t5 == 0 ? 0 : (t5 < 3 ? 3 + t5 : 5 + t5)) : (t5 < 3 ? 1 + t5 : 3 + t5); return true; }
        int wgid = (int)L; { const int q = nwg / NXCD, r = nwg % NXCD, xcd = wgid % NXCD, off = wgid / NXCD; wgid = (xcd < r ? xcd * (q + 1) : r * (q + 1) + (xcd - r) * q) + off; }
        const int nig = WGM * nN, gid = wgid / nig, fm = gid * WGM, gsz = (nM - fm) < WGM ? (nM - fm) : WGM;
        u.pm = fm + ((wgid % nig) % gsz); u.pn = (wgid % nig) / gsz; return true;
    }
};
template <class Epi, bool PERM = true, bool DBLK = false>
__device__ __forceinline__ void gemm_phase(LAS unsigned char* lds, const Gemm g, const StaticOrder& S, const Epi& E, const int tid) {
    const int wid = __builtin_amdgcn_readfirstlane(tid >> 6), lane = tid & 63, wr = wid >> 2, wc = wid & 3, fr = lane & 15, fq = lane >> 4;
    const int K = g.K, nt = K / BK;
    unsigned voffA[2], voffB[2];
#pragma unroll
    for (int i = 0; i < 2; ++i) { int R, C; stage_rc(tid * 16 + i * 8192, R, C); const int Rb = PERM ? ((R & ~31) + perm32(R & 31)) : R;
        voffA[i] = (unsigned)(R * K + C) * 2u; voffB[i] = (unsigned)(Rb * K + C) * 2u; }
    const size_t kstep = (size_t)(BK * 2);
    const size_t hstep = (size_t)HALF * K * 2;
    const size_t tstep = 2 * hstep;
    const unsigned ldsw = (unsigned)wid * 1024u;
    const int aoff = lds_byte(wr * 64 + fr, fq * 8), boff = lds_byte(wc * 32 + fr, fq * 8);
#define PG8_SA(b, h) (((b) * 2 + (h)) * HTB)
#define PG8_SB(b, h) ((4 + (b) * 2 + (h)) * HTB)
#define PG8_STAGE(bufoff, gbase, voff) do { _Pragma("unroll") for (int _i = 0; _i < 2; ++_i) \
        __builtin_amdgcn_global_load_lds((const unsigned*)((const char*)(gbase) + (voff)[_i]), (LAS unsigned*)(lds + (bufoff) + ldsw + _i * 8192), 16, 0, 0); } while (0)
#define PG8_LDA(dst, b, h) do { _Pragma("unroll") for (int m = 0; m < 4; ++m) _Pragma("unroll") for (int k = 0; k < 2; ++k) dst[m][k] = *(const LAS bf16x8*)(lds + PG8_SA(b, h) + aoff + m * 2048 + k * 1024); } while (0)
#define PG8_LDB(dst, b, h) do { _Pragma("unroll") for (int n = 0; n < 2; ++n) _Pragma("unroll") for (int k = 0; k < 2; ++k) dst[n][k] = *(const LAS bf16x8*)(lds + PG8_SB(b, h) + boff + n * 2048 + k * 1024); } while (0)
#define PG8_MMA(ai, bj, At, Bt) do { __builtin_amdgcn_s_setprio(1); _Pragma("unroll") for (int m = 0; m < 4; ++m) _Pragma("unroll") for (int n = 0; n < 2; ++n) _Pragma("unroll") for (int k = 0; k < 2; ++k) \
        acc[ai][bj][m][n] = __builtin_amdgcn_mfma_f32_16x16x32_bf16(Bt[n][k], At[m][k], acc[ai][bj][m][n], 0, 0, 0); __builtin_amdgcn_s_setprio(0); } while (0)
#define PG8_WAIT_V(n) asm volatile("s_waitcnt vmcnt(" #n ")" ::: "memory")
#define PG8_WAIT_L(n) asm volatile("s_waitcnt lgkmcnt(" #n ")" ::: "memory")
#define PG8_BAR __builtin_amdgcn_s_barrier()
#define PG8_SCHED __builtin_amdgcn_sched_barrier(0)
    Unit cur, nxt; int ui = 0;
    if (!S.next(0, cur)) return;
    f32x4 acc[2][2][4][2];
#pragma unroll
    for (int a = 0; a < 2; ++a)
#pragma unroll
        for (int b = 0; b < 2; ++b)
#pragma unroll
            for (int m = 0; m < 4; ++m)
#pragma unroll
                for (int n = 0; n < 2; ++n) acc[a][b][m][n] = (f32x4){0.f, 0.f, 0.f, 0.f};
    bf16x8 At[4][2], B0[2][2], B1[2][2];
    const char* cA = (const char*)g.A + (size_t)cur.pm * tstep; const char* cB = (const char*)g.Bt + (size_t)cur.pn * tstep;
    PG8_STAGE(PG8_SB(0, 0), cB, voffB); PG8_STAGE(PG8_SB(0, 1), cB + hstep, voffB); PG8_STAGE(PG8_SA(0, 0), cA, voffA); PG8_STAGE(PG8_SA(0, 1), cA + hstep, voffA);
    if (wr == 1) PG8_BAR;
    PG8_WAIT_V(2); PG8_BAR;
    PG8_STAGE(PG8_SB(1, 0), cB + kstep, voffB); PG8_STAGE(PG8_SA(1, 0), cA + kstep, voffA); PG8_STAGE(PG8_SB(1, 1), cB + hstep + kstep, voffB);
    PG8_WAIT_V(6); PG8_BAR;
    for (;;) {
        const bool has_next = S.next(ui + 1, nxt);
        const char* nA = has_next ? (const char*)g.A + (size_t)nxt.pm * tstep : cA; const char* nB = has_next ? (const char*)g.Bt + (size_t)nxt.pn * tstep : cB;
        for (int t2 = 0; t2 < (DBLK ? 2 * nt : nt); t2 += 2) {
            const int t = DBLK ? (t2 >= nt ? t2 - nt : t2) : t2;
            const bool lastp = (t == nt - 2);
            const bool last = DBLK ? (t2 == 2 * nt - 2) : lastp;
            const char* a1 = cA + (size_t)(t + 1) * kstep;
            const char* a2 = last ? nA : (lastp ? cA : cA + (size_t)(t + 2) * kstep); const char* b2 = last ? nB : (lastp ? cB : cB + (size_t)(t + 2) * kstep);
            const char* a3 = a2 + kstep; const char* b3 = b2 + kstep;
            PG8_LDB(B0, 0, 0); PG8_LDB(B1, 0, 1); PG8_SCHED; PG8_LDA(At, 0, 0); PG8_STAGE(PG8_SA(1, 1), a1 + hstep, voffA);
            PG8_WAIT_V(8); PG8_WAIT_L(0); PG8_BAR; PG8_MMA(0, 0, At, B0); PG8_MMA(0, 1, At, B1); PG8_BAR; PG8_SCHED;
            PG8_LDA(At, 0, 1); PG8_STAGE(PG8_SB(0, 0), b2, voffB); PG8_STAGE(PG8_SB(0, 1), b2 + hstep, voffB); PG8_STAGE(PG8_SA(0, 0), a2, voffA);
            PG8_WAIT_V(8); PG8_WAIT_L(0); PG8_BAR; PG8_MMA(1, 0, At, B0); PG8_MMA(1, 1, At, B1); PG8_BAR; PG8_SCHED;
            PG8_LDB(B0, 1, 0); PG8_LDB(B1, 1, 1); PG8_SCHED; PG8_LDA(At, 1, 0); PG8_STAGE(PG8_SA(0, 1), a2 + hstep, voffA);
            PG8_WAIT_V(8); PG8_WAIT_L(0); PG8_BAR; PG8_MMA(0, 0, At, B0); PG8_MMA(0, 1, At, B1); PG8_BAR; PG8_SCHED;
            PG8_LDA(At, 1, 1); PG8_STAGE(PG8_SB(1, 0), b3, voffB); PG8_STAGE(PG8_SB(1, 1), b3 + hstep, voffB); PG8_STAGE(PG8_SA(1, 0), a3, voffA);
            PG8_WAIT_V(8); PG8_WAIT_L(0); PG8_BAR; PG8_MMA(1, 0, At, B0); PG8_MMA(1, 1, At, B1); PG8_BAR; PG8_SCHED;
        }
        if (wr == 0) PG8_BAR;
        if (DBLK) {
#pragma unroll
            for (int a = 0; a < 2; ++a)
#pragma unroll
                for (int b = 0; b < 2; ++b)
#pragma unroll
                    for (int m = 0; m < 4; ++m)
#pragma unroll
                        for (int n = 0; n < 2; ++n) acc[a][b][m][n] *= 0.5f;
        }
        if (!Epi::AFTER_DRAIN || has_next) E(acc, cur, wr, wc, fr, fq);
        if (!has_next) break;
#pragma unroll
        for (int a = 0; a < 2; ++a)
#pragma unroll
            for (int b = 0; b < 2; ++b)
#pragma unroll
                for (int m = 0; m < 4; ++m)
#pragma unroll
                    for (int n = 0; n < 2; ++n) acc[a][b][m][n] = (f32x4){0.f, 0.f, 0.f, 0.f};
        cur = nxt; cA = nA; cB = nB; ++ui;
        if (wr == 1) PG8_BAR;
    }
    PG8_WAIT_V(0);
    PG8_BAR;
    if constexpr (Epi::AFTER_DRAIN) E.fused(acc, cur, wr, wc, lds);
#undef PG8_SA
#undef PG8_SB
#undef PG8_STAGE
#undef PG8_LDA
#undef PG8_LDB
#undef PG8_MMA
#undef PG8_WAIT_V
#undef PG8_WAIT_L
#undef PG8_BAR
#undef PG8_SCHED
}
}

struct EpiZ {
    static constexpr bool AFTER_DRAIN = false;
    bf16_t* Z; bf16_t* CQ; bf16_t* MISC; const float* ssq;
    DI void operator()(const f32x4 (&acc)[2][2][4][2], const pg8::Unit& u, int wr, int wc, int, int) const {
        const int lane_ = fresh_lane(), fr = lane_ & 15, fq = lane_ >> 4; (void)lane_;
        const int row0 = u.pm * 256 + wr * 64 + fr;
        bf16_t* base; int ldc, colt;
        if (u.pn == 6) { base = CQ; ldc = 256; colt = 0; }
        else if (u.pn == 7) { base = MISC; ldc = 256; colt = 0; }
        else { base = Z; ldc = ZLD; colt = (u.pn < 6 ? u.pn : u.pn - 2) * 256; }
        const int col0 = colt + wc * 32 + 8 * fq;
        float rs[2][4];
#pragma unroll
        for (int ai = 0; ai < 2; ++ai)
#pragma unroll
            for (int m = 0; m < 4; ++m) {
                const f32x4* sp = (const f32x4*)(ssq + (size_t)(row0 + ai * 128 + m * 16) * 16); const f32x4 q0 = sp[0], q1 = sp[1], q2 = sp[2], q3 = sp[3];
                rs[ai][m] = rsqrtf((((q0.x + q0.y) + (q0.z + q0.w)) + ((q1.x + q1.y) + (q1.z + q1.w)) + ((q2.x + q2.y) + (q2.z + q2.w)) + ((q3.x + q3.y) + (q3.z + q3.w))) * (1.0f / DM) + EPS);
            }
#pragma unroll
        for (int ai = 0; ai < 2; ++ai)
#pragma unroll
            for (int m = 0; m < 4; ++m) {
                const int r = row0 + ai * 128 + m * 16;
                bf16_t* rowp = base + (size_t)r * ldc + col0;
#pragma unroll
                for (int bj = 0; bj < 2; ++bj) {
                    const f32x4 v0 = acc[ai][bj][m][0] * rs[ai][m], v1 = acc[ai][bj][m][1] * rs[ai][m];
                    u32x4 w; w.x = pk2(v0[0], v0[1]); w.y = pk2(v0[2], v0[3]); w.z = pk2(v1[0], v1[1]); w.w = pk2(v1[2], v1[3]);
                    *(u32x4*)(rowp + bj * 128) = w;
                }
            }
    }
};
struct EpiRaw {
    static constexpr bool AFTER_DRAIN = false;
    bf16_t* O; int ldc;
    DI void operator()(const f32x4 (&acc)[2][2][4][2], const pg8::Unit& u, int wr, int wc, int, int) const {
        const int lane_ = fresh_lane(), fr = lane_ & 15, fq = lane_ >> 4; (void)lane_;
        const int row0 = u.pm * 256 + wr * 64 + fr;
        const int col0 = u.pn * 256 + wc * 32 + 8 * fq;
#pragma unroll
        for (int ai = 0; ai < 2; ++ai)
#pragma unroll
            for (int m = 0; m < 4; ++m) {
                bf16_t* rowp = O + (size_t)(row0 + ai * 128 + m * 16) * ldc + col0;
#pragma unroll
                for (int bj = 0; bj < 2; ++bj) {
                    const f32x4 v0 = acc[ai][bj][m][0], v1 = acc[ai][bj][m][1];
                    u32x4 w; w.x = pk2(v0[0], v0[1]); w.y = pk2(v0[2], v0[3]); w.z = pk2(v1[0], v1[1]); w.w = pk2(v1[2], v1[3]);
                    *(u32x4*)(rowp + bj * 128) = w;
                }
            }
    }
};
struct EpiUp {
    static constexpr bool AFTER_DRAIN = false;
    bf16_t* QRp; bf16_t* KVRp;
    DI void operator()(const f32x4 (&acc)[2][2][4][2], const pg8::Unit& u, int wr, int wc, int, int) const {
        const int lane_ = fresh_lane(), fr = lane_ & 15, fq = lane_ >> 4; (void)lane_;
        const bool isq = u.pm < 64;
        bf16_t* O = isq ? QRp : KVRp; const int ldc = isq ? 768 : 1024;
        const int row0 = (isq ? u.pm : u.pm - 64) * 256 + wr * 64 + fr;
        const int col0 = (isq ? u.pn : u.pn - 3) * 256 + wc * 32 + 8 * fq;
#pragma unroll
        for (int ai = 0; ai < 2; ++ai)
#pragma unroll
            for (int m = 0; m < 4; ++m) {
                bf16_t* rowp = O + (size_t)(row0 + ai * 128 + m * 16) * ldc + col0;
#pragma unroll
                for (int bj = 0; bj < 2; ++bj) {
                    const f32x4 v0 = acc[ai][bj][m][0], v1 = acc[ai][bj][m][1];
                    u32x4 w; w.x = pk2(v0[0], v0[1]); w.y = pk2(v0[2], v0[3]); w.z = pk2(v1[0], v1[1]); w.w = pk2(v1[2], v1[3]);
                    *(u32x4*)(rowp + bj * 128) = w;
                }
            }
    }
};
struct EpiOut {
    static constexpr bool AFTER_DRAIN = true;
    const float* xin; float* xout; bf16_t* XB; float* ssq_next;
    template <int B> DI void load(f32x4 (&xv)[2][4], int row0, int col0) const {
#pragma unroll
        for (int q = 0; q < 2; ++q)
#pragma unroll
            for (int bj = 0; bj < 2; ++bj) { const size_t off = (size_t)(row0 + (B >> 1) * 128 + (2 * (B & 1) + q) * 16) * DM + col0 + bj * 128;
                xv[q][bj * 2] = *(const f32x4*)(xin + off); xv[q][bj * 2 + 1] = *(const f32x4*)(xin + off + 16); }
    }
    template <int B> DI void proc(const f32x4 (&acc)[2][2][4][2], const f32x4 (&xv)[2][4], int row0, int col0, int pn, int wc, int fq, int lane_) const {
#pragma unroll
        for (int q = 0; q < 2; ++q) {
            constexpr int ai = B >> 1; const int m = 2 * (B & 1) + q;
            const int r = row0 + ai * 128 + m * 16;
            float part = 0.f;
#pragma unroll
            for (int bj = 0; bj < 2; ++bj) {
                const size_t off = (size_t)r * DM + col0 + bj * 128;
                const f32x4 v0 = acc[ai][bj][m][0] + xv[q][bj * 2], v1 = acc[ai][bj][m][1] + xv[q][bj * 2 + 1];
                *(f32x4*)(xout + off) = v0; *(f32x4*)(xout + off + 16) = v1;
                if (XB) {
                    *(u32x2*)(XB + off) = (u32x2){pk2(v0[0], v0[1]), pk2(v0[2], v0[3])};
                    *(u32x2*)(XB + off + 16) = (u32x2){pk2(v1[0], v1[1]), pk2(v1[2], v1[3])};
                    part += (v0[0] * v0[0] + v0[1] * v0[1]) + (v0[2] * v0[2] + v0[3] * v0[3]) + (v1[0] * v1[0] + v1[1] * v1[1]) + (v1[2] * v1[2] + v1[3] * v1[3]);
                }
            }
            if (XB) {
                part += shx(part, 16, lane_); part += shx(part, 32, lane_);
                if (fq == 0) ssq_next[(size_t)r * 16 + pn * 4 + wc] = part;
            }
        }
    }
    DI void fused(const f32x4 (&acc)[2][2][4][2], const pg8::Unit& u, int wr, int wc, LAS unsigned char* lds) const {
        const int lane_ = fresh_lane(), fr = lane_ & 15, fq = lane_ >> 4;
        const int w8 = wr * 4 + wc;
#pragma unroll
        for (int ai = 0; ai < 2; ++ai) {
#pragma unroll
            for (int m = 0; m < 4; ++m)
#pragma unroll
                for (int bj = 0; bj < 2; ++bj)
#pragma unroll
                    for (int n = 0; n < 2; ++n)
                        *(LAS f32x4*)(lds + (size_t)(wr * 64 + m * 16 + fr) * 1040 + (bj * 128 + wc * 32 + n * 16 + 4 * fq) * 4) = acc[ai][bj][m][n];
            __syncthreads();
            const size_t g0 = (size_t)(u.pm * 256 + ai * 128 + w8 * 16) * DM + u.pn * 256 + lane_ * 4;
            f32x4 xo[16];
#pragma unroll
            for (int rr = 0; rr < 16; ++rr) xo[rr] = *(const f32x4*)(xin + g0 + (size_t)rr * DM);
#pragma unroll
            for (int rr = 0; rr < 16; ++rr) {
                const f32x4 a = *(const LAS f32x4*)(lds + (size_t)(w8 * 16 + rr) * 1040 + lane_ * 16);
                const f32x4 v = a + xo[rr];
                *(f32x4*)(xout + g0 + (size_t)rr * DM) = v;
                if (XB) {
                    *(u32x2*)(XB + g0 + (size_t)rr * DM) = (u32x2){pk2(v[0], v[1]), pk2(v[2], v[3])};
                    float part = (v[0] * v[0] + v[1] * v[1]) + (v[2] * v[2] + v[3] * v[3]);
                    part = wave_sum(part, lane_);
                    if (lane_ < 4) ssq_next[(size_t)(u.pm * 256 + ai * 128 + w8 * 16 + rr) * 16 + u.pn * 4 + lane_] = (lane_ == 0) ? part : 0.f;
                }
            }
            __syncthreads();
        }
    }
    DI void operator()(const f32x4 (&acc)[2][2][4][2], const pg8::Unit& u, int wr, int wc, int, int) const {
        const int lane_ = fresh_lane(), fr = lane_ & 15, fq = lane_ >> 4;
        const int row0 = u.pm * 256 + wr * 64 + fr;
        const int col0 = u.pn * 256 + wc * 32 + 4 * fq;
        f32x4 xa[2][4], xb[2][4];
        load<0>(xa, row0, col0); load<1>(xb, row0, col0);
        proc<0>(acc, xa, row0, col0, u.pn, wc, fq, lane_); load<2>(xa, row0, col0);
        proc<1>(acc, xb, row0, col0, u.pn, wc, fq, lane_); load<3>(xb, row0, col0);
        proc<2>(acc, xa, row0, col0, u.pn, wc, fq, lane_);
        proc<3>(acc, xb, row0, col0, u.pn, wc, fq, lane_);
    }
};

struct Params {
    const float* x; const int* pos; const float* norm_g; const float* w_in; const float* w_gate_up; const float* b_gate;
    const float* gla_norm_g; const float* q_norm_g; const float* w_uq; const float* kv_norm_g; const float* w_ukv;
    const float* q_head_g; const float* k_head_g; const float* w_out;
    float* out; unsigned char* ws;
};

DI int map_in(int n) { return n < 1024 ? n : (n < 1984 ? n + 16 : (n < 2000 ? n - 960 : (n < 2048 ? -1 : n - 48))); }
DI void tr_item(const float* W, int ldw, const float* gain, bf16_t* WT, int ldk, int k0, int n0, bool remap, LAS float* scr, int lane) {
    const int nq = (lane & 7) * 4, kr = lane >> 3; const int nn = n0 + nq; const int src = remap ? map_in(nn) : nn;
    f32x4 v[8];
#pragma unroll
    for (int i = 0; i < 8; ++i) { const int kk = 8 * i + kr;
        v[i] = (f32x4){0.f, 0.f, 0.f, 0.f}; if (src >= 0) { v[i] = *(const f32x4*)(W + (size_t)(k0 + kk) * ldw + src); if (gain) v[i] = v[i] * gain[k0 + kk]; } }
#pragma unroll
    for (int i = 0; i < 8; ++i) *(LAS f32x4*)(scr + (8 * i + kr) * 36 + nq) = v[i];
    asm volatile("s_waitcnt lgkmcnt(0)" ::: "memory");
    const int c = lane & 7;
#pragma unroll
    for (int j = 0; j < 4; ++j) { const int n = (lane >> 3) + 8 * j; const LAS float* s = scr + (8 * c) * 36 + n;
        u32x4 o; o.x = pk2(s[0 * 36], s[1 * 36]); o.y = pk2(s[2 * 36], s[3 * 36]); o.z = pk2(s[4 * 36], s[5 * 36]); o.w = pk2(s[6 * 36], s[7 * 36]);
        *(u32x4*)(WT + (size_t)(n0 + n) * ldk + k0 + 8 * c) = o; }
    asm volatile("s_waitcnt lgkmcnt(0)" ::: "memory");
}
DI void p0_prologue(const Params& p, LAS unsigned char* lds, int tid, int lane, int wave) {
    unsigned char* ws = p.ws;
    LAS float* scr = (LAS float*)(lds + wave * 9216);
    const int gw = blockIdx.x * 8 + wave, NGW = gridDim.x * 8;
    const int gt = blockIdx.x * 512 + tid, NT = gridDim.x * 512;
    constexpr int IT_IN = 16 * 80, IT_OUT = 16 * 32, IT_UQ = 4 * 24, IT_UKV = 2 * 32, IT_L = IT_IN + IT_OUT + IT_UQ + IT_UKV;
    for (int it = gw; it < DEPTH * IT_L; it += NGW) {
        const int l = it / IT_L; int r = it % IT_L;
        if (r < IT_IN) { tr_item(p.w_in + (size_t)l * DM * DIN, DIN, p.norm_g + l * DM, (bf16_t*)(ws + WS_WIN) + (size_t)l * N1 * DM, DM, 64 * (r / 80), 32 * (r % 80), true, scr, lane); continue; } r -= IT_IN;
        if (r < IT_OUT) { tr_item(p.w_out + (size_t)l * DM * DM, DM, nullptr, (bf16_t*)(ws + WS_WOUT) + (size_t)l * DM * DM, DM, 64 * (r / 32), 32 * (r % 32), false, scr, lane); continue; } r -= IT_OUT;
        if (r < IT_UQ) { tr_item(p.w_uq + (size_t)l * 256 * 768, 768, p.q_norm_g + l * 256, (bf16_t*)(ws + WS_WUP) + (size_t)l * WUP_ROWS * 256, 256, 64 * (r / 24), 32 * (r % 24), false, scr, lane); continue; } r -= IT_UQ;
        tr_item(p.w_ukv + (size_t)l * 128 * 1024, 1024, p.kv_norm_g + l * 128, (bf16_t*)(ws + WS_WUP) + ((size_t)l * WUP_ROWS + 768) * 256, 256, 64 * (r / 32), 32 * (r % 32), false, scr, lane);
    }
    for (int i = gt; i < DEPTH * 1024 * 16; i += NT) { const int ln = i >> 4, c = i & 15; *(u32x4*)((bf16_t*)(ws + WS_WUP) + ((size_t)(ln >> 10) * WUP_ROWS + 768 + (ln & 1023)) * 256 + 128 + c * 8) = (u32x4){0u, 0u, 0u, 0u}; }
    for (int i = gt; i < DEPTH * 256 * 16; i += NT) { const int r = i & 15, c = (i >> 4) & 255, ll = i >> 12; ((float*)(ws + WS_WGT))[i] = p.w_gate_up[((size_t)ll * 16 + r) * 256 + c]; }
    for (int i = gt; i < 3072; i += NT) { float v; if (i < 1024) v = p.b_gate[i]; else if (i < 1536) v = p.gla_norm_g[i - 1024]; else if (i < 2304) v = p.q_head_g[i - 1536]; else v = p.k_head_g[i - 2304]; ((float*)(ws + WS_SM))[i] = v; }
    float* COS = (float*)(ws + WS_COS); float* SIN = (float*)(ws + WS_SIN);
    for (int i = gt; i < T * 32; i += NT) { const int t = i >> 5, j = i & 31;
        const float inv = exp2f(-(float)j * (13.287712379549449f / 32.0f));
        const float ang = (float)p.pos[t] * inv;
        const float n = rintf(ang * 0.15915494309189535f);
        float r = fmaf(-n, 6.2831855f, ang); r = fmaf(-n, -1.7484555e-7f, r);
        COS[i] = __cosf(r); SIN[i] = __sinf(r); }
    float* SSQ = (float*)(ws + WS_SSQ); bf16_t* XB = (bf16_t*)(ws + WS_XB);
    for (int m0 = gw * 4; m0 < T; m0 += NGW * 4) {
        f32x4 v[4][4];
#pragma unroll
        for (int q = 0; q < 4; ++q)
#pragma unroll
            for (int j = 0; j < 4; ++j) v[q][j] = ((const f32x4*)(p.x + (size_t)(m0 + q) * DM) + lane)[64 * j];
#pragma unroll
        for (int q = 0; q < 4; ++q) {
            float s = 0.f;
            unsigned long long* o8 = (unsigned long long*)(XB + (size_t)(m0 + q) * DM) + lane;
#pragma unroll
            for (int j = 0; j < 4; ++j) { const f32x4 w = v[q][j]; s += (w.x * w.x + w.y * w.y) + (w.z * w.z + w.w * w.w);
                o8[64 * j] = (unsigned long long)pk2(w.x, w.y) | ((unsigned long long)pk2(w.z, w.w) << 32); }
            s = wave_sum(s, lane); if (lane < 16) SSQ[(size_t)(m0 + q) * 16 + lane] = (lane == 0) ? s : 0.f;
        }
    }
}

constexpr int GS = 80;
constexpr int GL_QD = 0, GL_KI = 10240, GL_AT = 20480, GL_VT = 30720, GL_SP = 51200, GL_LR = 71680, GL_TOT = 75776, GL_RS = 77824, GL_GT = 79872  , GL_OT = 97280  , GL_UT = 0  ;
DI float logsigmoid16(float x) { return (fminf(x, 0.f) - __logf(1.f + __expf(-fabsf(x)))) * (1.0f / 16.0f); }
#define MFMA16(a, b, c) __builtin_amdgcn_mfma_f32_16x16x32_bf16((a), (b), (c), 0, 0, 0)
#define MFMA32(a, b, c) __builtin_amdgcn_mfma_f32_32x32x16_bf16((a), (b), (c), 0, 0, 0)
DI bf16x8 lds_frag(LAS unsigned char* lds, int base, int row, int kel) { return *(const LAS bf16x8*)(lds + base + row * (2 * GS) + kel * 2); }

template <bool P3> struct GlaIn;
template <> struct GlaIn<false> { u32x4 vt[2]; unsigned lr[2]; unsigned kq[8]; f32x4 wup[4]; float bias; };
template <> struct GlaIn<true>  { u32x4 vt[2]; u32x4 bc; unsigned kq[8]; f32x4 sp[4]; u32x4 gt[2]; float gn[4]; };

template <bool P3> DI void gla_load(const Params& p, int l, int item, int tid, int lane, int wave, GlaIn<P3>& g) {
    const int c = item >> 2, h = item & 3, t0 = c * 64;
    const bf16_t* Z = (const bf16_t*)(p.ws + WS_Z); const bf16_t* MISC = (const bf16_t*)(p.ws + WS_MISC);
#pragma unroll
    for (int e = 0; e < 2; ++e) g.vt[e] = *(const u32x4*)(Z + (size_t)(t0 + lane) * ZLD + Z_GV + h * 128 + (wave + 8 * e) * 8);
    if constexpr (!P3) {
#pragma unroll
        for (int e = 0; e < 2; ++e) { const int i = tid + e * 512; g.lr[e] = MISC[(size_t)(t0 + (i >> 4)) * 256 + 192 + (i & 15)]; }
    } else g.bc = *(const u32x4*)((const unsigned short*)(p.ws + WS_BC) + ((size_t)item * 64 + lane) * 64 + wave * 8);
#pragma unroll
    for (int jj = 0; jj < 8; ++jj) { const size_t ro = (size_t)(t0 + wave * 8 + jj) * ZLD + h * 64 + lane;
        unsigned v = Z[ro + Z_GK]; if (P3) v |= (unsigned)Z[ro + Z_GQ] << 16; g.kq[jj] = v; }
    if constexpr (!P3) {
        const f32x4* wp = (const f32x4*)((const float*)(p.ws + WS_WGT) + ((size_t)l * 256 + h * 64 + lane) * 16);
#pragma unroll
        for (int q = 0; q < 4; ++q) g.wup[q] = wp[q];
        g.bias = ((const float*)(p.ws + WS_SM))[l * 256 + h * 64 + lane];
    }
    if constexpr (P3) {
        const f32x4* SP = (const f32x4*)((const float*)(p.ws + WS_XB) + (size_t)item * 8192);
#pragma unroll
        for (int e = 0; e < 4; ++e) g.sp[e] = SP[tid + e * 512];
#pragma unroll
        for (int e = 0; e < 2; ++e) { const int cc = tid + e * 512; g.gt[e] = *(const u32x4*)(Z + (size_t)(t0 + (cc >> 4)) * ZLD + Z_GG + h * 128 + (cc & 15) * 8); }
        const int hf = wave >> 2, fr = lane & 15;
#pragma unroll
        for (int n = 0; n < 4; ++n) g.gn[n] = ((const float*)(p.ws + WS_SM))[1024 + l * 128 + hf * 64 + n * 16 + fr];
    }
}
template <bool P3> DI void gla_vt(const GlaIn<P3>& g, LAS unsigned char* lds, int lane, int wave) {
    { LAS bf16_t* VTt = (LAS bf16_t*)(lds + GL_VT);
#pragma unroll
      for (int e = 0; e < 2; ++e) { const int dv0 = (wave + 8 * e) * 8; const u32x4 w = g.vt[e];
          VTt[(dv0 + 0) * GS + lane] = (bf16_t)(w.x & 0xffffu); VTt[(dv0 + 1) * GS + lane] = (bf16_t)(w.x >> 16);
          VTt[(dv0 + 2) * GS + lane] = (bf16_t)(w.y & 0xffffu); VTt[(dv0 + 3) * GS + lane] = (bf16_t)(w.y >> 16);
          VTt[(dv0 + 4) * GS + lane] = (bf16_t)(w.z & 0xffffu); VTt[(dv0 + 5) * GS + lane] = (bf16_t)(w.z >> 16);
          VTt[(dv0 + 6) * GS + lane] = (bf16_t)(w.w & 0xffffu); VTt[(dv0 + 7) * GS + lane] = (bf16_t)(w.w >> 16); } }
}
DI void gla_front(const GlaIn<false>& g, LAS unsigned char* lds, int tid, int lane, int wave, float (&bv)[8], float& blast) {
    LAS float* LR = (LAS float*)(lds + GL_LR);
    LAS float* TOT = (LAS float*)(lds + GL_TOT);
    gla_vt<false>(g, lds, lane, wave);
#pragma unroll
    for (int e = 0; e < 2; ++e) LR[tid + e * 512] = bflo(g.lr[e]);
    __syncthreads();
    float run = 0.f;
#pragma unroll
    for (int jj = 0; jj < 8; ++jj) { const int j = wave * 8 + jj; float lg = g.bias;
#pragma unroll
        for (int q = 0; q < 4; ++q) { const f32x4 lv = *(const LAS f32x4*)(LR + j * 16 + q * 4); lg = fmaf(lv.x, g.wup[q].x, lg); lg = fmaf(lv.y, g.wup[q].y, lg); lg = fmaf(lv.z, g.wup[q].z, lg); lg = fmaf(lv.w, g.wup[q].w, lg); }
        run += logsigmoid16(lg); bv[jj] = run; }
    TOT[wave * 64 + lane] = run;
    __syncthreads();
    float off = 0.f, tot = 0.f;
#pragma unroll
    for (int s = 0; s < 8; ++s) { const float v = TOT[s * 64 + lane]; if (s < wave) off += v; tot += v; }
#pragma unroll
    for (int jj = 0; jj < 8; ++jj) bv[jj] += off;
    blast = tot;
}

DI void gla_compute1(const Params& p, int l, int item, const GlaIn<false>& g, LAS unsigned char* lds, int tid, int lane, int wave) {
    float* UPD = (float*)(p.ws + WS_XB); float* DEC = (float*)(p.ws + WS_DEC);
    float bv[8], blast;
    gla_front(g, lds, tid, lane, wave, bv, blast);
    {
        unsigned q[8];
#pragma unroll
        for (int jj = 0; jj < 8; ++jj) q[jj] = (unsigned)fminf(fmaf(-bv[jj], 4096.f, 0.5f), 65535.f);
        const u32x4 hw = {q[0] | (q[1] << 16), q[2] | (q[3] << 16), q[4] | (q[5] << 16), q[6] | (q[7] << 16)};
        *(u32x4*)((unsigned short*)(p.ws + WS_BC) + ((size_t)item * 64 + lane) * 64 + wave * 8) = hw;
    }
    {
        unsigned w[4];
#pragma unroll
        for (int q = 0; q < 4; ++q) w[q] = pk2(bflo(g.kq[2 * q]) * __expf(blast - bv[2 * q]), bflo(g.kq[2 * q + 1]) * __expf(blast - bv[2 * q + 1]));
        *(LAS u32x4*)(lds + GL_QD + lane * (2 * GS) + wave * 16) = (u32x4){w[0], w[1], w[2], w[3]};
        if (wave == 0) DEC[item * 64 + lane] = __expf(blast);
    }
    __syncthreads();
    const int fr = lane & 15, fq = lane >> 4;
    f32x4 acc[4];
#pragma unroll
    for (int n = 0; n < 4; ++n) acc[n] = (f32x4){0.f, 0.f, 0.f, 0.f};
#pragma unroll
    for (int ks = 0; ks < 2; ++ks) {
        const bf16x8 a = lds_frag(lds, GL_VT, wave * 16 + fr, ks * 32 + fq * 8);
#pragma unroll
        for (int n = 0; n < 4; ++n) { const bf16x8 b = lds_frag(lds, GL_QD, n * 16 + fr, ks * 32 + fq * 8); acc[n] = MFMA16(a, b, acc[n]); }
    }
    if (item >= 608) {
        if (tid == 0) { const unsigned* ctr = (const unsigned*)p.ws + CW_LATE + 64 * l; while (__hip_atomic_load(ctr, __ATOMIC_RELAXED, __HIP_MEMORY_SCOPE_AGENT) < 128u) __builtin_amdgcn_s_sleep(2); }
    }
    __syncthreads();
    LAS float* UT = (LAS float*)(lds + GL_UT);
#pragma unroll
    for (int n = 0; n < 4; ++n)
#pragma unroll
        for (int r = 0; r < 4; ++r) UT[(wave * 16 + fq * 4 + r) * 68 + n * 16 + fr] = acc[n][r];
    __syncthreads();
    f32x4* up = (f32x4*)(UPD + (size_t)item * 8192);
#pragma unroll
    for (int e = 0; e < 4; ++e) { const int cc = tid + e * 512; up[cc] = *(const LAS f32x4*)(UT + (cc >> 4) * 68 + (cc & 15) * 4); }
    __syncthreads();
}

DI void gla_compute3(const Params& p, int item, const GlaIn<true>& g, LAS unsigned char* lds, int tid, int lane, int wave) {
    const int c = item >> 2, h = item & 3, t0 = c * 64;
    bf16_t* OB = (bf16_t*)(p.ws + WS_KVR);
    float bv[8], blast;
#pragma unroll
    for (int e = 0; e < 4; ++e) { const int i4 = tid + e * 512; const f32x4 v = g.sp[e]; const int dv = i4 >> 4, k4 = (i4 & 15) * 4;
        *(LAS u32x2*)(lds + GL_SP + dv * (2 * GS) + k4 * 2) = (u32x2){pk2(v.x, v.y), pk2(v.z, v.w)}; }
#pragma unroll
    for (int e = 0; e < 2; ++e) { const int cc = tid + e * 512; *(LAS u32x4*)(lds + GL_GT + (cc >> 4) * 272 + (cc & 15) * 16) = g.gt[e]; }
    gla_vt<true>(g, lds, lane, wave);
    {   const unsigned w4[4] = {g.bc.x, g.bc.y, g.bc.z, g.bc.w};
#pragma unroll
        for (int q = 0; q < 4; ++q) { bv[2 * q] = (float)(w4[q] & 0xffffu) * (-1.0f / 4096.f); bv[2 * q + 1] = (float)(w4[q] >> 16) * (-1.0f / 4096.f); }
        blast = 0.f; (void)blast; }
    {
        LAS bf16_t* QD = (LAS bf16_t*)(lds + GL_QD); LAS bf16_t* KI = (LAS bf16_t*)(lds + GL_KI);
#pragma unroll
        for (int jj = 0; jj < 8; ++jj) { const int j = wave * 8 + jj;
            const float q = bfhi(g.kq[jj]) * 0.125f * __expf(bv[jj]);
            const float k = bflo(g.kq[jj]) * __expf(-bv[jj]);
            QD[j * GS + lane] = f2bf(q); KI[j * GS + lane] = f2bf(k); }
    }
    __syncthreads();
    const int fr = lane & 15, fq = lane >> 4;
    {
        const int mt = wave >> 1, nb = (wave & 1) * 2;
        f32x4 a2[2] = {(f32x4){0.f, 0.f, 0.f, 0.f}, (f32x4){0.f, 0.f, 0.f, 0.f}};
#pragma unroll
        for (int ks = 0; ks < 2; ++ks) { const bf16x8 a = lds_frag(lds, GL_QD, mt * 16 + fr, ks * 32 + fq * 8);
#pragma unroll
            for (int n = 0; n < 2; ++n) { const bf16x8 b = lds_frag(lds, GL_KI, (nb + n) * 16 + fr, ks * 32 + fq * 8); a2[n] = MFMA16(a, b, a2[n]); } }
        LAS bf16_t* AT = (LAS bf16_t*)(lds + GL_AT);
#pragma unroll
        for (int n = 0; n < 2; ++n)
#pragma unroll
            for (int r = 0; r < 4; ++r) { const int i = mt * 16 + fq * 4 + r, j = (nb + n) * 16 + fr; AT[i * GS + j] = f2bf(j <= i ? a2[n][r] : 0.f); }
    }
    __syncthreads();
    const int mt = wave & 3, hf = wave >> 2;
    f32x4 acc[4];
#pragma unroll
    for (int n = 0; n < 4; ++n) acc[n] = (f32x4){0.f, 0.f, 0.f, 0.f};
#pragma unroll
    for (int ks = 0; ks < 2; ++ks) {
        const bf16x8 a1 = lds_frag(lds, GL_AT, mt * 16 + fr, ks * 32 + fq * 8);
        const bf16x8 a2 = lds_frag(lds, GL_QD, mt * 16 + fr, ks * 32 + fq * 8);
#pragma unroll
        for (int n = 0; n < 4; ++n) {
            const bf16x8 b1 = lds_frag(lds, GL_VT, hf * 64 + n * 16 + fr, ks * 32 + fq * 8);
            const bf16x8 b2 = lds_frag(lds, GL_SP, hf * 64 + n * 16 + fr, ks * 32 + fq * 8);
            acc[n] = MFMA16(a1, b1, acc[n]); acc[n] = MFMA16(a2, b2, acc[n]); }
    }
    LAS float* RS = (LAS float*)(lds + GL_RS);
    float ss[4];
#pragma unroll
    for (int r = 0; r < 4; ++r) { float s = 0.f;
#pragma unroll
        for (int n = 0; n < 4; ++n) s += acc[n][r] * acc[n][r];
        ss[r] = red16(s, lane); }
    if (fr == 0) {
#pragma unroll
        for (int r = 0; r < 4; ++r) RS[(mt * 16 + fq * 4 + r) * 2 + hf] = ss[r]; }
    __syncthreads();
    {
        const LAS bf16_t* GTt = (const LAS bf16_t*)(lds + GL_GT); LAS bf16_t* OTt = (LAS bf16_t*)(lds + GL_OT);
#pragma unroll
        for (int r = 0; r < 4; ++r) { const int i = mt * 16 + fq * 4 + r; const float rstd = rsqrtf((RS[i * 2] + RS[i * 2 + 1]) * (1.0f / 128.0f) + EPS);
#pragma unroll
            for (int n = 0; n < 4; ++n) { const int dv = hf * 64 + n * 16 + fr;
                const float gg = bf2f(GTt[i * 136 + dv]);
                OTt[i * 136 + dv] = f2bf(acc[n][r] * rstd * g.gn[n] * (gg / (1.f + __expf(-gg)))); } }
    }
    __syncthreads();
#pragma unroll
    for (int e = 0; e < 2; ++e) { const int cc = tid + e * 512;
        *(u32x4*)(OB + (size_t)(t0 + (cc >> 4)) * DM + h * 128 + (cc & 15) * 8) = *(const LAS u32x4*)(lds + GL_OT + (cc >> 4) * 272 + (cc & 15) * 16); }
    __syncthreads();
}
template <bool P3> DI void gla_pass(const Params& p, int l, LAS unsigned char* lds, int tid, int lane, int wave, int first, int step, int nitems) {
    int it = first; if (it >= nitems) return;
    GlaIn<P3> cur; gla_load<P3>(p, l, it & 1023, tid, lane, wave, cur);
    for (;;) {
        const int nx = it + step; const bool has = nx < nitems;
        GlaIn<P3> nxt; gla_load<P3>(p, l, (has ? nx : it) & 1023, tid, lane, wave, nxt);
        if constexpr (P3) gla_compute3(p, it & 1023, cur, lds, tid, lane, wave); else gla_compute1(p, l, it & 1023, cur, lds, tid, lane, wave);
        if (!has) break;
        cur = nxt; it = nx;
    }
}

DI void gla_scan(const Params& p, int tid, LAS unsigned char* lds) {
    float* UPD = (float*)(p.ws + WS_XB); const float* DEC = (const float*)(p.ws + WS_DEC);
    LAS float* DL = (LAS float*)lds;
    for (int e0 = blockIdx.x * 512; e0 < 16 * 8192; e0 += gridDim.x * 512) {
        const int e = e0 + tid;
        const int bh = e >> 13, idx = e & 8191, k = idx & 63, b = bh >> 2, h = bh & 3;
        float* up0 = UPD + (size_t)((b * 64) << 2) * 8192 + (size_t)h * 8192 + idx; const float* dp0 = DEC + (((b * 64) << 2) + h) * 64;
#pragma unroll
        for (int q = 0; q < 8; ++q) { const int i = tid + q * 512; DL[i] = dp0[(i >> 6) * 4 * 64 + (i & 63)]; }
        __syncthreads();
        float S = 0.f;
#pragma unroll
        for (int n0 = 0; n0 < 64; n0 += 32) {
            float u[32];
#pragma unroll
            for (int n = 0; n < 32; ++n) u[n] = up0[(size_t)(n0 + n) * 4 * 8192];
#pragma unroll
            for (int n = 0; n < 32; ++n) { up0[(size_t)(n0 + n) * 4 * 8192] = S; S = fmaf(DL[(n0 + n) * 64 + k], S, u[n]); }
        }
        __syncthreads();
    }
}

constexpr float QSCALE = 0.07216878364870322f * 1.4426950408889634f;
DI void unpack8(const u32x4 w, float (&v)[8]) { v[0] = bflo(w.x); v[1] = bfhi(w.x); v[2] = bflo(w.y); v[3] = bfhi(w.y); v[4] = bflo(w.z); v[5] = bfhi(w.z); v[6] = bflo(w.w); v[7] = bfhi(w.w); }
DI void finalize_tile(const Params& p, int l, int tile, LAS unsigned char* lds, int tid, int lane, int wave, const bool doq = true) {
    unsigned char* ws = p.ws;
    const bf16_t* CQ = (const bf16_t*)(ws + WS_CQ); const bf16_t* MISC = (const bf16_t*)(ws + WS_MISC);
    bf16_t* QR = (bf16_t*)(ws + WS_QR); const bf16_t* KVR = (const bf16_t*)(ws + WS_KVR); bf16_t* KB = (bf16_t*)(ws + WS_K); bf16_t* VT = (bf16_t*)(ws + WS_VT);
    const float* COS = (const float*)(ws + WS_COS); const float* SIN = (const float*)(ws + WS_SIN);
    LAS bf16_t* VL = (LAS bf16_t*)lds;
    const int sub = lane >> 4, i = lane & 15;
    const int t0 = tile * 64;
    const float* qg = (const float*)(p.ws + WS_SM) + 1536 + l * 192; const float* kg = (const float*)(p.ws + WS_SM) + 2304 + l * 192;
#pragma unroll
    for (int it = 0; it < 2; ++it) {
        const int tl = wave * 8 + it * 4 + sub; const size_t t = (size_t)(t0 + tl);
        const u32x4 c0 = *(const u32x4*)(CQ + t * 256 + 16 * i), c1 = *(const u32x4*)(CQ + t * 256 + 16 * i + 8);
        const u32x4 kvw = *(const u32x4*)(MISC + t * 256 + 8 * i);
        const unsigned p1 = *(const unsigned*)(MISC + t * 256 + 128 + 2 * i), p2 = *(const unsigned*)(MISC + t * 256 + 160 + 2 * i);
        const f32x2 cs = *(const f32x2*)(COS + t * 32 + 2 * i), sn = *(const f32x2*)(SIN + t * 32 + 2 * i);
        float v[8], w[8]; float s1 = 0.f, s2 = 0.f;
        unpack8(c0, v); unpack8(c1, w);
#pragma unroll
        for (int e = 0; e < 8; ++e) s1 += v[e] * v[e] + w[e] * w[e];
        unpack8(kvw, v);
#pragma unroll
        for (int e = 0; e < 8; ++e) s2 += v[e] * v[e];
        const float x1a = bflo(p1), x1b = bfhi(p1), x2a = bflo(p2), x2b = bfhi(p2);
        float s3 = (x1a * x1a + x1b * x1b) + (x2a * x2a + x2b * x2b);
        s1 = red16(s1, lane); s2 = red16(s2, lane); s3 = red16(s3, lane);
        const float rcq = rsqrtf(s1 * (1.0f / 256.0f) + EPS), rckv = rsqrtf(s2 * (1.0f / 128.0f) + EPS);
        u32x4 qa4[4], ka4[4], va4[4]; unsigned r14[4], r24[4];
#pragma unroll
        for (int h = 0; h < 4; ++h) { const bf16_t* qp = QR + t * 768 + h * 192; const bf16_t* kp = KVR + t * 1024 + h * 256;
            qa4[h] = *(const u32x4*)(qp + 8 * i); r14[h] = *(const unsigned*)(qp + 128 + 2 * i); r24[h] = *(const unsigned*)(qp + 160 + 2 * i);
            ka4[h] = *(const u32x4*)(kp + 8 * i); va4[h] = *(const u32x4*)(kp + 128 + 8 * i); }
        const f32x4 qg0 = *(const f32x4*)(qg + 8 * i), qg1 = *(const f32x4*)(qg + 8 * i + 4), kg0 = *(const f32x4*)(kg + 8 * i), kg1 = *(const f32x4*)(kg + 8 * i + 4);
        const f32x2 qgr1 = *(const f32x2*)(qg + 128 + 2 * i), qgr2 = *(const f32x2*)(qg + 160 + 2 * i), kgr1 = *(const f32x2*)(kg + 128 + 2 * i), kgr2 = *(const f32x2*)(kg + 160 + 2 * i);
        if (doq)
#pragma unroll
        for (int h = 0; h < 4; ++h) {
            bf16_t* qp = QR + t * 768 + h * 192;
            const u32x4 qa = qa4[h]; const unsigned r1 = r14[h], r2 = r24[h];
            unpack8(qa, v);
            const float y1a = bflo(r1) * rcq, y1b = bfhi(r1) * rcq, y2a = bflo(r2) * rcq, y2b = bfhi(r2) * rcq;
            float ss = (y1a * y1a + y1b * y1b) + (y2a * y2a + y2b * y2b);
#pragma unroll
            for (int e = 0; e < 8; ++e) { v[e] *= rcq; ss += v[e] * v[e]; }
            ss = red16(ss, lane);
            const float rq = rsqrtf(ss * (1.0f / 192.0f) + EPS) * QSCALE;
            const f32x4 g0 = qg0, g1 = qg1; const f32x2 gr1 = qgr1, gr2 = qgr2;
            u32x4 o; o.x = pk2(v[0] * rq * g0.x, v[1] * rq * g0.y); o.y = pk2(v[2] * rq * g0.z, v[3] * rq * g0.w); o.z = pk2(v[4] * rq * g1.x, v[5] * rq * g1.y); o.w = pk2(v[6] * rq * g1.z, v[7] * rq * g1.w);
            *(u32x4*)(qp + 8 * i) = o;
            const float a1 = y1a * rq * gr1.x, b1 = y1b * rq * gr1.y, a2 = y2a * rq * gr2.x, b2 = y2b * rq * gr2.y;
            *(unsigned*)(qp + 128 + 2 * i) = pk2(a1 * cs.x - a2 * sn.x, b1 * cs.y - b2 * sn.y);
            *(unsigned*)(qp + 160 + 2 * i) = pk2(a1 * sn.x + a2 * cs.x, b1 * sn.y + b2 * cs.y);
        }
#pragma unroll
        for (int h = 0; h < 4; ++h) {
            const u32x4 ka = ka4[h], va = va4[h];
            unpack8(ka, v);
            float ss = 0.f;
#pragma unroll
            for (int e = 0; e < 8; ++e) { v[e] *= rckv; ss += v[e] * v[e]; }
            ss = red16(ss, lane) + s3;
            const float rk = rsqrtf(ss * (1.0f / 192.0f) + EPS);
            const f32x4 g0 = kg0, g1 = kg1; const f32x2 gr1 = kgr1, gr2 = kgr2;
            bf16_t* ko = KB + t * 768 + h * 192;
            u32x4 o; o.x = pk2(v[0] * rk * g0.x, v[1] * rk * g0.y); o.y = pk2(v[2] * rk * g0.z, v[3] * rk * g0.w); o.z = pk2(v[4] * rk * g1.x, v[5] * rk * g1.y); o.w = pk2(v[6] * rk * g1.z, v[7] * rk * g1.w);
            *(u32x4*)(ko + 8 * i) = o;
            const float a1 = x1a * rk * gr1.x, b1 = x1b * rk * gr1.y, a2 = x2a * rk * gr2.x, b2 = x2b * rk * gr2.y;
            *(unsigned*)(ko + 128 + 2 * i) = pk2(a1 * cs.x - a2 * sn.x, b1 * cs.y - b2 * sn.y);
            *(unsigned*)(ko + 160 + 2 * i) = pk2(a1 * sn.x + a2 * cs.x, b1 * sn.y + b2 * cs.y);
            unpack8(va, w);
            u32x4 vo; vo.x = pk2(w[0] * rckv, w[1] * rckv); vo.y = pk2(w[2] * rckv, w[3] * rckv); vo.z = pk2(w[4] * rckv, w[5] * rckv); vo.w = pk2(w[6] * rckv, w[7] * rckv);
            *(LAS u32x4*)(VL + tl * 512 + h * 128 + 8 * i) = vo;
        }
    }
    __syncthreads();
    {
        const int b = t0 >> 12, s0 = t0 & 4095, h = tid >> 7, dv = tid & 127;
        bf16_t* dst = VT + ((size_t)((b * 4 + h) * 128 + dv)) * SEQ + s0;
#pragma unroll
        for (int q = 0; q < 8; ++q) { unsigned wv[4];
#pragma unroll
            for (int e = 0; e < 4; ++e) wv[e] = (unsigned)VL[(q * 8 + 2 * e) * 512 + tid] | ((unsigned)VL[(q * 8 + 2 * e + 1) * 512 + tid] << 16);
            *(u32x4*)(dst + q * 8) = (u32x4){wv[0], wv[1], wv[2], wv[3]}; }
    }
    __syncthreads();
}

constexpr int AT_KB = 25600, AT_VB = 17408, AT_K0 = 0, AT_V0 = 2 * AT_KB, AT_MB = 0;
DI void attn_unit(const Params& p, int b, int h, int qb, LAS unsigned char* lds, int tid, int lane, int wave) {
    unsigned char* ws = p.ws;
    const bf16_t* Q = (const bf16_t*)(ws + WS_QR); const bf16_t* KB = (const bf16_t*)(ws + WS_K); const bf16_t* VT = (const bf16_t*)(ws + WS_VT);
    const bf16_t* Z = (const bf16_t*)(ws + WS_Z); bf16_t* OB = (bf16_t*)(ws + WS_KVR);
    const int g = wave >> 2, w4 = wave & 3, r = lane & 31, hh = lane >> 5;
    const int qr0 = qb * 128 + w4 * 32, nst = 2 * (qb + 1);
    const size_t tokb = (size_t)b * SEQ;
    bf16x8 qf[12];
    { const bf16_t* qp = Q + (tokb + qr0 + r) * 768 + h * 192 + 8 * hh;
#pragma unroll
      for (int kk = 0; kk < 12; ++kk) qf[kk] = *(const bf16x8*)(qp + 16 * kk); }
    f32x16 o[4];
#pragma unroll
    for (int i = 0; i < 4; ++i)
#pragma unroll
        for (int j = 0; j < 16; ++j) o[i][j] = 0.f;
    float mrow = -INFINITY, lrow = 0.f;
    const bf16_t* kbase = KB + tokb * 768 + h * 192;
    const bf16_t* vbase = VT + (size_t)((b * 4 + h) * 128) * SEQ;
    int krow[3], kcol[3];
#pragma unroll
    for (int e = 0; e < 3; ++e) { const int c = tid + 512 * e; krow[e] = c / 24; kcol[e] = c % 24; }
    u32x4 pk[3], pv[2];
#define AT_LOAD(st) do { _Pragma("unroll") for (int e = 0; e < 3; ++e) pk[e] = *(const u32x4*)(kbase + (size_t)((st) * 64 + krow[e]) * 768 + kcol[e] * 8); \
        _Pragma("unroll") for (int e = 0; e < 2; ++e) { const int c = tid + 512 * e; pv[e] = *(const u32x4*)(vbase + (size_t)(c >> 3) * SEQ + (st) * 64 + (c & 7) * 8); } } while (0)
#define AT_WRITE(buf) do { _Pragma("unroll") for (int e = 0; e < 3; ++e) *(LAS u32x4*)(lds + AT_K0 + (buf) * AT_KB + krow[e] * 400 + kcol[e] * 16) = pk[e]; \
        _Pragma("unroll") for (int e = 0; e < 2; ++e) { const int c = tid + 512 * e; LAS u32x2* vd_ = (LAS u32x2*)(lds + AT_V0 + (buf) * AT_VB + (c >> 3) * 136 + (c & 7) * 16); vd_[0] = (u32x2){pv[e].x, pv[e].y}; vd_[1] = (u32x2){pv[e].z, pv[e].w}; } } while (0)
    AT_LOAD(0); AT_WRITE(0);
    __syncthreads();
    for (int st = 0; st < nst; ++st) {
        const int buf = st & 1;
        if (st + 1 < nst) AT_LOAD(st + 1);
        const int kb = st * 64 + g * 32;
        if (kb <= qr0 + 31) {
            f32x16 s;
#pragma unroll
            for (int j = 0; j < 16; ++j) s[j] = 0.f;
            const LAS unsigned char* kp = lds + AT_K0 + buf * AT_KB + (g * 32 + r) * 400 + hh * 16;
            bf16x8 kf[12];
#pragma unroll
            for (int kk = 0; kk < 12; ++kk) kf[kk] = *(const LAS bf16x8*)(kp + kk * 32);
            __builtin_amdgcn_sched_barrier(0);
            __builtin_amdgcn_s_setprio(1);
#pragma unroll
            for (int kk = 0; kk < 12; ++kk) s = MFMA32(kf[kk], qf[kk], s);
            __builtin_amdgcn_s_setprio(0);
            const LAS unsigned char* vp = lds + AT_V0 + buf * AT_VB + r * 136 + (g * 32 + 4 * hh) * 2;
            bf16x8 vf[2][4];
#pragma unroll
            for (int ks = 0; ks < 2; ++ks)
#pragma unroll
                for (int blk = 0; blk < 4; ++blk) {
                    const s16x4 lo = *(const LAS s16x4*)(vp + blk * 32 * 136 + ks * 32), hi = *(const LAS s16x4*)(vp + blk * 32 * 136 + ks * 32 + 16);
                    vf[ks][blk] = __builtin_shufflevector(lo, hi, 0, 1, 2, 3, 4, 5, 6, 7);
                }
            __builtin_amdgcn_sched_barrier(0);
            if (kb + 31 > qr0) {
                const int qa = qr0 + r - kb - 4 * hh;
#pragma unroll
                for (int j = 0; j < 16; ++j) if ((j & 3) + 8 * (j >> 2) > qa) s[j] = -INFINITY;
            }
            float mx = fmaxf(fmaxf(fmaxf(s[0], s[1]), fmaxf(s[2], s[3])), fmaxf(fmaxf(s[4], s[5]), fmaxf(s[6], s[7])));
            mx = fmaxf(mx, fmaxf(fmaxf(fmaxf(s[8], s[9]), fmaxf(s[10], s[11])), fmaxf(fmaxf(s[12], s[13]), fmaxf(s[14], s[15]))));
            { const u32x2 sw = __builtin_amdgcn_permlane32_swap(__float_as_uint(mx), __float_as_uint(mx), false, false);
              mx = fmaxf(__uint_as_float(sw.x), __uint_as_float(sw.y)); }
            if (__builtin_amdgcn_ballot_w64(mx > mrow + 8.0f) != 0ull) {
                const float mnew = fmaxf(mrow, mx);
                const float alpha = (mnew == -INFINITY) ? 1.0f : __builtin_amdgcn_exp2f(mrow - mnew);
                mrow = mnew; lrow *= alpha;
#pragma unroll
                for (int i = 0; i < 4; ++i)
#pragma unroll
                    for (int j = 0; j < 16; ++j) o[i][j] *= alpha;
            }
            const float muse = (mrow == -INFINITY) ? 0.f : mrow;
            float ps = 0.f;
#pragma unroll
            for (int j = 0; j < 16; ++j) { s[j] = __builtin_amdgcn_exp2f(s[j] - muse); ps += s[j]; }
            lrow += ps;
#pragma unroll
            for (int ks = 0; ks < 2; ++ks) {
                u32x4 pw; pw.x = pk2(s[8 * ks], s[8 * ks + 1]); pw.y = pk2(s[8 * ks + 2], s[8 * ks + 3]); pw.z = pk2(s[8 * ks + 4], s[8 * ks + 5]); pw.w = pk2(s[8 * ks + 6], s[8 * ks + 7]);
                const bf16x8 pf = __builtin_bit_cast(bf16x8, pw);
                __builtin_amdgcn_s_setprio(1);
#pragma unroll
                for (int blk = 0; blk < 4; ++blk) o[blk] = MFMA32(vf[ks][blk], pf, o[blk]);
                __builtin_amdgcn_s_setprio(0);
            }
        }
        if (st + 1 < nst) AT_WRITE(buf ^ 1);
        __syncthreads();
    }
#undef AT_LOAD
#undef AT_WRITE
    { const u32x2 sw_ = __builtin_amdgcn_permlane32_swap(__float_as_uint(lrow), __float_as_uint(lrow), false, false); lrow = __uint_as_float(sw_.x) + __uint_as_float(sw_.y); }
    LAS float* MB = (LAS float*)(lds + AT_MB) + w4 * 66 * 64 + lane;
    if (g == 1) {
#pragma unroll
        for (int i = 0; i < 4; ++i)
#pragma unroll
            for (int j = 0; j < 16; ++j) MB[(i * 16 + j) * 64] = o[i][j];
        MB[64 * 64] = mrow; MB[65 * 64] = lrow;
    }
    __syncthreads();
    if (g == 0) {
        const float m1 = MB[64 * 64], l1 = MB[65 * 64];
        const float m = fmaxf(mrow, m1);
        const float a0 = __builtin_amdgcn_exp2f(mrow - m), a1 = __builtin_amdgcn_exp2f(m1 - m);
        const float inv = 1.0f / (lrow * a0 + l1 * a1);
        const size_t tok = tokb + qr0 + r;
        const bf16_t* gp = Z + tok * ZLD + Z_MG + h * 128 + 4 * hh;
        bf16_t* op = OB + tok * DM + 512 + h * 128 + 4 * hh;
        u32x2 gw[4][4];
#pragma unroll
        for (int i = 0; i < 4; ++i)
#pragma unroll
            for (int q = 0; q < 4; ++q) gw[i][q] = *(const u32x2*)(gp + i * 32 + q * 8);
#pragma unroll
        for (int i = 0; i < 4; ++i)
#pragma unroll
            for (int q = 0; q < 4; ++q) {
                float gv[4] = {bflo(gw[i][q].x), bfhi(gw[i][q].x), bflo(gw[i][q].y), bfhi(gw[i][q].y)}; float ov[4];
#pragma unroll
                for (int e = 0; e < 4; ++e) { const float val = (o[i][q * 4 + e] * a0 + MB[(i * 16 + q * 4 + e) * 64] * a1) * inv; ov[e] = val * (gv[e] / (1.f + __expf(-gv[e]))); }
                *(u32x2*)(op + i * 32 + q * 8) = (u32x2){pk2(ov[0], ov[1]), pk2(ov[2], ov[3])};
            }
    }
    __syncthreads();
}


#define XB_TMO      128
#define XB_XCNT(j)  (256  + 64 * (j))
#define XB_XSUB(j)  (1280 + 64 * (j))
#define XB_XGEN(j)  (2304 + 64 * (j))
#define XB_TOP      3328
#define XB_TOPGEN   3392
#define XCD_BAR_WORDS 3456
#define XB_SPIN_CAP (1u << 18)
DI unsigned xb_ld(unsigned* p)              { return __hip_atomic_load(p, __ATOMIC_RELAXED, __HIP_MEMORY_SCOPE_AGENT); }
DI unsigned xb_add(unsigned* p, unsigned v) { return __hip_atomic_fetch_add(p, v, __ATOMIC_RELAXED, __HIP_MEMORY_SCOPE_AGENT); }
DI unsigned xb_xcc_id() { return (unsigned)__builtin_amdgcn_s_getreg((3 << 11) | 20) & 0xFu; }
#define XB_SPIN(cond, bar) do { unsigned _sp = 0; while (cond) { __builtin_amdgcn_s_sleep(1); \
    if ((++_sp & 255u) == 0u) { if (xb_ld(&(bar)[XB_TMO])) break; if (_sp > XB_SPIN_CAP) { atomicAdd(&(bar)[XB_TMO], 1u); break; } } } } while (0)
struct XcdBarrier { unsigned* bar; unsigned x; volatile LAS unsigned* st; };
DI XcdBarrier xcd_barrier_post(unsigned* bar, volatile LAS unsigned* st) {
    XcdBarrier b; b.bar = bar; b.x = xb_xcc_id(); b.st = st;
    if (threadIdx.x == 0) (void)xb_add(&bar[XB_XCNT(b.x)], 1u);
    return b;
}
DI void xcd_barrier_complete(unsigned* bar, unsigned x, unsigned& nloc, unsigned& nx) {
    const unsigned G = gridDim.x * gridDim.y * gridDim.z;
    unsigned sum, cnt, mine, sp = 0u;
    for (;;) {
        sum = 0u; cnt = 0u; mine = 0u;
#pragma unroll
        for (unsigned j = 0; j < 16; ++j) { const unsigned c = xb_ld(&bar[XB_XCNT(j)]); sum += c; cnt += (c > 0u) ? 1u : 0u; mine = (j == x) ? c : mine; }
        if (sum == G) break;
        __builtin_amdgcn_s_sleep(1);
        if ((++sp & 255u) == 0u) { if (xb_ld(&bar[XB_TMO])) break; if (sp > XB_SPIN_CAP) { atomicAdd(&bar[XB_TMO], 1u); break; } }
    }
    nloc = mine > 0u ? mine : 1u; nx = cnt > 0u ? cnt : 1u;
}
DI void xcd_barrier(unsigned* bar_, LAS unsigned char* lds_) {
    XcdBarrier b; b.bar = bar_; b.x = xb_xcc_id(); b.st = (volatile LAS unsigned*)(lds_ + LDS_BYTES - 64);
    asm volatile("s_waitcnt vmcnt(0)" ::: "memory");
    __syncthreads();
    if (threadIdx.x == 0) {
        unsigned* bar = b.bar;
        __builtin_amdgcn_s_waitcnt(0);
        unsigned nloc = b.st[0], nx = b.st[1];
        if (nloc == 0u) { xcd_barrier_complete(bar, b.x, nloc, nx); b.st[0] = nloc; b.st[1] = nx; }
        const unsigned old = xb_add(&bar[XB_XSUB(b.x)], 1u);
        const unsigned gen = old / nloc;
        if (old + 1u == (gen + 1u) * nloc) {
            __builtin_amdgcn_fence(__ATOMIC_RELEASE, "agent");
            asm volatile("s_waitcnt vmcnt(0)" ::: "memory");
            const unsigned og = xb_add(&bar[XB_TOP], 1u);
            const unsigned tg = og / nx;
            if (og + 1u == (tg + 1u) * nx) xb_add(&bar[XB_TOPGEN], 1u);
            else XB_SPIN(xb_ld(&bar[XB_TOPGEN]) == tg, bar);
            __builtin_amdgcn_fence(__ATOMIC_ACQUIRE, "agent");
            xb_add(&bar[XB_XGEN(b.x)], 1u);
            asm volatile("s_waitcnt vmcnt(0)" ::: "memory");
        } else {
            XB_SPIN(xb_ld(&bar[XB_XGEN(b.x)]) == gen, bar);
            __builtin_amdgcn_fence(__ATOMIC_ACQUIRE, "agent");
            asm volatile("s_waitcnt vmcnt(0)" ::: "memory");
        }
    }
    __syncthreads();
}

#define FRESH() const int lane = fresh_lane(); int wave = wave_s; asm volatile("" : "+s"(wave)); const int tid = wave * 64 + lane; (void)tid; unsigned char* ws = p.ws; asm volatile("" : "+s"(ws)); (void)ws; Params pl = p; pl.ws = ws; (void)pl
__global__ void __launch_bounds__(512, 2) hymba_fwd(Params p) {
    extern __shared__ __attribute__((aligned(16))) unsigned char lds_raw[];
    LAS unsigned char* lds = (LAS unsigned char*)lds_raw;
    cg::grid_group grid = cg::this_grid();
    if (threadIdx.x < 2) ((volatile LAS unsigned*)(lds + LDS_BYTES - 64))[threadIdx.x] = 0u;
    __syncthreads();
    (void)xcd_barrier_post((unsigned*)p.ws, (volatile LAS unsigned*)(lds + LDS_BYTES - 64));
    const int wave_s = __builtin_amdgcn_readfirstlane(threadIdx.x >> 6);
    const int G = gridDim.x, bx = blockIdx.x;
    const int vcu = (G % 8 == 0) ? (bx % 8) * (G / 8) + bx / 8 : bx;

#ifndef PHMASK
#define PHMASK 0xffff
#endif
#ifndef DUPMASK
#define DUPMASK 0
#endif
#if PHMASK & 1
    for (int rep = 0; rep < ((DUPMASK & 1) ? 2 : 1); ++rep) { FRESH(); p0_prologue(pl, lds, tid, lane, wave); __syncthreads(); }
#endif
    xcd_barrier((unsigned*)p.ws, lds);
    if (gridDim.x == 0x7fffffffu) grid.sync();

    for (int l = 0; l < DEPTH; ++l) {
        for (int ph = 0; ph < 2; ++ph) {
#if PHMASK & 2
            { FRESH(); float* SSQ = (float*)(ws + WS_SSQ);
                pg8::Gemm g{(const bf16_t*)(ws + WS_XB), (const bf16_t*)(ws + WS_WIN) + (size_t)l * N1 * DM, T, N1, DM};
                pg8::StaticOrder S; if (ph == 0) S.init_in(vcu, G, 512); else if (G == 256) S.init_in((vcu & 1) ? 640 : 512 + (vcu >> 1), 640, 640); else S.init_in(512 + vcu, G, 640);
                EpiZ E{(bf16_t*)(ws + WS_Z), (bf16_t*)(ws + WS_CQ), (bf16_t*)(ws + WS_MISC), SSQ};
                pg8::gemm_phase<EpiZ, true, (DUPMASK & 4096) != 0>(lds, g, S, E, tid);
                __syncthreads();
                if (ph == 1) {
                    const int nmine = (G == 256) ? ((vcu & 1) ? 0 : 1) : ((vcu < 128) ? (128 - vcu + G - 1) / G : 0);
                    if (nmine > 0 && threadIdx.x == 0) __hip_atomic_fetch_add((unsigned*)p.ws + CW_LATE + 64 * l, (unsigned)nmine, __ATOMIC_RELAXED, __HIP_MEMORY_SCOPE_AGENT);
                }
            }
#endif
            if (ph == 0) {
                xcd_barrier((unsigned*)p.ws, lds);
#if DUPMASK & 512
                xcd_barrier((unsigned*)p.ws, lds);
#endif
            }
        }
        const bool bal = (G == 256);
        const bool heavy = bal && !(vcu & 1);
        const int hv = vcu >> 1;
#if PHMASK & 4
        { FRESH();
            pg8::Gemm g{(const bf16_t*)(ws + WS_CQ), (const bf16_t*)(ws + WS_WUP) + (size_t)l * WUP_ROWS * 256, 2 * T, WUP_ROWS, 256};
            pg8::StaticOrder S;
            if (!bal) S.init_up(vcu, G, 448); else if (heavy) S.init_up(hv, 448, 448); else S.init_up(128 + hv, 128, 448);
            EpiUp E{(bf16_t*)(ws + WS_QR), (bf16_t*)(ws + WS_KVR)};
            pg8::gemm_phase<EpiUp>(lds, g, S, E, tid);
        }
        __syncthreads();
#endif
#if PHMASK & 8
        { FRESH();
            int first, step, lim;
            if (!bal) { first = vcu; step = G; lim = 1024; } else if (heavy) { first = 640 + hv * 3; step = 1; lim = first + 3; } else { first = hv * 5; step = 1; lim = first + 5; }
            gla_pass<false>(p, l, lds, tid, lane, wave, first, step, lim); }
#endif
        xcd_barrier((unsigned*)p.ws, lds);
#if DUPMASK & 512
        xcd_barrier((unsigned*)p.ws, lds);
#endif
#if PHMASK & 16
        for (int it = bx; it < 256; it += G) { FRESH(); finalize_tile(pl, l, it, lds, tid, lane, wave); }
#if DUPMASK & 16
        for (int it = bx; it < 256; it += G) { FRESH(); finalize_tile(pl, l, it, lds, tid, lane, wave, false); }
#endif
#endif
#if PHMASK & 32
        { FRESH(); gla_scan(pl, tid, lds); }
#endif
        xcd_barrier((unsigned*)p.ws, lds);
#if DUPMASK & 512
        xcd_barrier((unsigned*)p.ws, lds);
#endif
#if PHMASK & 64
        for (int pr = vcu; pr < ((DUPMASK & 64) ? 512 : 256); pr += G) {
            const int bh = (pr >> 4) & 15, i = pr & 15;
            { FRESH(); attn_unit(p, bh >> 2, bh & 3, 31 - i, lds, tid, lane, wave); }
            { FRESH(); attn_unit(p, bh >> 2, bh & 3, i, lds, tid, lane, wave); }
        }
#endif
#if PHMASK & 128
        { FRESH(); gla_pass<true>(p, l, lds, tid, lane, wave, bx, G, (DUPMASK & 128) ? 2048 : 1024); }
#endif
        xcd_barrier((unsigned*)p.ws, lds);
#if DUPMASK & 512
        xcd_barrier((unsigned*)p.ws, lds);
#endif
#if PHMASK & 256
        for (int rep = 0; rep < (((DUPMASK & 256) && l == 0) ? 2 : 1); ++rep) { FRESH(); float* SSQ = (float*)(ws + WS_SSQ);
            pg8::Gemm g{(const bf16_t*)(ws + WS_KVR), (const bf16_t*)(ws + WS_WOUT) + (size_t)l * DM * DM, T, DM, DM};
            pg8::StaticOrder S; S.init(T, DM, G, bx);
            const bool lastl = (l == DEPTH - 1);
            EpiOut E{l == 0 ? p.x : p.out, p.out, lastl ? nullptr : (bf16_t*)(ws + WS_XB), lastl ? nullptr : SSQ};
            pg8::gemm_phase<EpiOut, false, (DUPMASK & 2048) != 0>(lds, g, S, E, tid);
            __syncthreads();
        }
#endif
        if (l + 1 < DEPTH) xcd_barrier((unsigned*)p.ws, lds);
    }
}


extern "C" void kernel_launch(void* const* d_in, const int* in_sizes, int n_in, void* d_out, int out_size, void* d_ws, size_t ws_size, hipStream_t stream) {
    static int grid = 0;
    if (grid == 0) {
        if (n_in != 14 || ws_size < WS_END) { fprintf(stderr, "kernel_launch: unexpected inputs (n_in %d, ws %zu)\n", n_in, ws_size); grid = -1; return; }
        int dev = 0, cus = 0, per_cu = 0;
        hipGetDevice(&dev);
        hipDeviceGetAttribute(&cus, hipDeviceAttributeMultiprocessorCount, dev);
        if (hipFuncSetAttribute((const void*)hymba_fwd, hipFuncAttributeMaxDynamicSharedMemorySize, LDS_BYTES) != hipSuccess) { fprintf(stderr, "kernel_launch: hipFuncSetAttribute failed\n"); grid = -1; return; }
        if (hipOccupancyMaxActiveBlocksPerMultiprocessor(&per_cu, (const void*)hymba_fwd, 512, LDS_BYTES) != hipSuccess || per_cu < 1) { fprintf(stderr, "kernel_launch: occupancy query gave %d\n", per_cu); per_cu = 1; }
        (void)hipGetLastError();
        grid = cus * per_cu;
        if (grid > 256) grid = 256;
    }
    if (grid < 0) return;
    Params p{};
    p.x = (const float*)d_in[0]; p.pos = (const int*)d_in[1]; p.norm_g = (const float*)d_in[2]; p.w_in = (const float*)d_in[3];
    p.w_gate_up = (const float*)d_in[4]; p.b_gate = (const float*)d_in[5]; p.gla_norm_g = (const float*)d_in[6]; p.q_norm_g = (const float*)d_in[7];
    p.w_uq = (const float*)d_in[8]; p.kv_norm_g = (const float*)d_in[9]; p.w_ukv = (const float*)d_in[10]; p.q_head_g = (const float*)d_in[11];
    p.k_head_g = (const float*)d_in[12]; p.w_out = (const float*)d_in[13];
    p.out = (float*)d_out; p.ws = (unsigned char*)d_ws;
    if (hipMemsetAsync(d_ws, 0, 65536, stream) != hipSuccess) { fprintf(stderr, "kernel_launch: memset failed\n"); return; }
    void* args[] = {&p};
    hipError_t e = hipLaunchCooperativeKernel((const void*)hymba_fwd, dim3(grid), dim3(512), args, LDS_BYTES, stream);
    if (e != hipSuccess) fprintf(stderr, "cooperative launch failed: %s (grid %d)\n", hipGetErrorString(e), grid);
}
```
